# Optimizing an MI355X kernel written in HIP

```python
import jax, jax.numpy as jnp
from jax import lax
import numpy as np

D_MODEL = 1024
BATCH = 32
SEQ = 2048
DEPTH = 1
DEC_BATCH = 2
DEC_SEQ = 8192
PAST_LEN = 128

N_FOURIER_GROUPS = 4
FOURIER_GROUP_DIM = 128
FOURIER_WIDTH = N_FOURIER_GROUPS * FOURIER_GROUP_DIM
N_SGU_GROUPS = 4
SGU_GROUP_DIM = 128
SGU_WIDTH = N_SGU_GROUPS * SGU_GROUP_DIM
CHUNK = 128
D_FF = 4 * D_MODEL
CONV_WIDTH = 3
IN_PROJ_WIDTH = FOURIER_WIDTH + 2 * SGU_WIDTH + 2 * D_MODEL
EPS = 1e-6

kernel_name = "fnet_gmlp_gated_hybrid_encoder"


def rmsnorm(x, g):
    xf = x.astype(jnp.float32)
    r = lax.rsqrt(jnp.mean(xf * xf, axis=-1, keepdims=True) + EPS)
    return (xf * r * g.astype(jnp.float32)).astype(x.dtype)


def layernorm(x, g, b):
    xf = x.astype(jnp.float32)
    mu = jnp.mean(xf, axis=-1, keepdims=True)
    var = jnp.mean(jnp.square(xf - mu), axis=-1, keepdims=True)
    y = (xf - mu) * lax.rsqrt(var + EPS) * g.astype(jnp.float32) + b.astype(jnp.float32)
    return y.astype(x.dtype)


def fourier_mix(f):
    b, s, _ = f.shape
    z = f.reshape(b, s, N_FOURIER_GROUPS, FOURIER_GROUP_DIM).astype(jnp.float32)
    z = jnp.fft.fft2(z, axes=(1, 3), norm="ortho").real
    return z.reshape(b, s, FOURIER_WIDTH).astype(f.dtype)


def spatial_gating(u, v, ln_g, ln_b, w_s, b_s):
    b, s, _ = v.shape
    v = layernorm(v, ln_g, ln_b)
    vc = v.reshape(b, s // CHUNK, CHUNK, N_SGU_GROUPS, SGU_GROUP_DIM)
    mixed = jnp.einsum('hpq,bnqhc->bnphc', w_s, vc) + b_s.T[:, :, None]
    return u * mixed.reshape(b, s, SGU_WIDTH)


def centred_depthwise_conv(x, w, bias):
    xp = jnp.pad(x, ((0, 0), (1, 1), (0, 0)))
    return xp[:, :-2] * w[0] + xp[:, 1:-1] * w[1] + xp[:, 2:] * w[2] + bias


def layer(x, norm_pre_mix, w_in, sgu_ln_g, sgu_ln_b, sgu_w_s, sgu_b_s,
          w_fourier_out, w_sgu_out, w_o, norm_post_mix, norm_pre_ffn,
          w_up, conv_w, conv_b, w_down, norm_post_ffn):
    h = rmsnorm(x, norm_pre_mix)
    proj = jnp.einsum('bsd,de->bse', h, w_in)
    o1 = FOURIER_WIDTH
    o2 = o1 + SGU_WIDTH
    o3 = o2 + SGU_WIDTH
    o4 = o3 + D_MODEL
    f = proj[..., :o1]
    u = jax.nn.gelu(proj[..., o1:o2])
    v = jax.nn.gelu(proj[..., o2:o3])
    gate_a = jax.nn.sigmoid(proj[..., o3:o4])
    gate_b = jax.nn.sigmoid(proj[..., o4:])
    y_a = jnp.einsum('bsc,cd->bsd', fourier_mix(f), w_fourier_out)
    y_b = jnp.einsum('bsc,cd->bsd', spatial_gating(u, v, sgu_ln_g, sgu_ln_b, sgu_w_s, sgu_b_s), w_sgu_out)
    merged = gate_a * y_a + gate_b * y_b
    x = x + rmsnorm(jnp.einsum('bsd,de->bse', merged, w_o), norm_post_mix)

    h2 = rmsnorm(x, norm_pre_ffn)
    up = jnp.einsum('bsd,df->bsf', h2, w_up)
    up = centred_depthwise_conv(up, conv_w, conv_b)
    act = jax.nn.gelu(up[..., :D_FF]) * up[..., D_FF:]
    ff = jnp.einsum('bsf,fd->bsd', act, w_down)
    return x + rmsnorm(ff, norm_post_ffn)


def setup_inputs(seed: int = 0) -> dict:
    key = jax.random.key(seed)
    ks = jax.random.split(key, 20)
    f32 = jnp.float32

    def nrm(k, shape, scale):
        return jax.random.normal(k, shape, f32) * scale

    def gain(k, n):
        return jnp.ones((DEPTH, n), f32) + nrm(k, (DEPTH, n), 0.02)

    return {
        "x_prompt": nrm(ks[0], (BATCH, SEQ, D_MODEL), 1.0),
        "x_sample": nrm(ks[1], (DEC_BATCH, DEC_SEQ, D_MODEL), 1.0),
        "norm_pre_mix": gain(ks[2], D_MODEL),
        "w_in": nrm(ks[3], (DEPTH, D_MODEL, IN_PROJ_WIDTH), D_MODEL ** -0.5),
        "sgu_ln_g": gain(ks[4], SGU_WIDTH),
        "sgu_ln_b": nrm(ks[5], (DEPTH, SGU_WIDTH), 0.02),
        "sgu_w_s": nrm(ks[6], (DEPTH, N_SGU_GROUPS, CHUNK, CHUNK), CHUNK ** -0.5),
        "sgu_b_s": nrm(ks[7], (DEPTH, N_SGU_GROUPS, CHUNK), 0.02),
        "w_fourier_out": nrm(ks[8], (DEPTH, FOURIER_WIDTH, D_MODEL), FOURIER_WIDTH ** -0.5),
        "w_sgu_out": nrm(ks[9], (DEPTH, SGU_WIDTH, D_MODEL), SGU_WIDTH ** -0.5),
        "w_o": nrm(ks[10], (DEPTH, D_MODEL, D_MODEL), D_MODEL ** -0.5),
        "norm_post_mix": gain(ks[11], D_MODEL),
        "norm_pre_ffn": gain(ks[12], D_MODEL),
        "w_up": nrm(ks[13], (DEPTH, D_MODEL, 2 * D_FF), D_MODEL ** -0.5),
        "conv_w": nrm(ks[14], (DEPTH, CONV_WIDTH, 2 * D_FF), CONV_WIDTH ** -0.5),
        "conv_b": nrm(ks[15], (DEPTH, 2 * D_FF), 0.02),
        "w_down": nrm(ks[16], (DEPTH, D_FF, D_MODEL), D_FF ** -0.5),
        "norm_post_ffn": gain(ks[17], D_MODEL),
    }


def reference(x_prompt, x_sample, norm_pre_mix, w_in, sgu_ln_g, sgu_ln_b, sgu_w_s, sgu_b_s,
              w_fourier_out, w_sgu_out, w_o, norm_post_mix, norm_pre_ffn,
              w_up, conv_w, conv_b, w_down, norm_post_ffn):
    y_prompt = x_prompt
    y_sample = x_sample
    for l in range(DEPTH):
        p = (norm_pre_mix[l], w_in[l], sgu_ln_g[l], sgu_ln_b[l], sgu_w_s[l], sgu_b_s[l],
             w_fourier_out[l], w_sgu_out[l], w_o[l], norm_post_mix[l], norm_pre_ffn[l],
             w_up[l], conv_w[l], conv_b[l], w_down[l], norm_post_ffn[l])
        y_prompt = layer(y_prompt, *p)
        y_sample = layer(y_sample, *p)
    return (y_prompt, y_sample)
```

```cpp
#include <hip/hip_runtime.h>
#include <hip/hip_cooperative_groups.h>
#include <cstdio>
#include <cstdint>
namespace cg = cooperative_groups;

#ifndef PROBE_P0MASK
#define PROBE_P0MASK 0x7f
#endif
#ifndef MK_MULTI
#define MK_MULTI 0
#endif

#define LAS __attribute__((address_space(3)))
typedef unsigned short bf16_t;
typedef short bf16x8 __attribute__((ext_vector_type(8)));
typedef float f32x4 __attribute__((ext_vector_type(4)));
typedef unsigned u32x4 __attribute__((ext_vector_type(4)));
typedef unsigned u32x2 __attribute__((ext_vector_type(2)));

constexpr int T = 81920, TP = 65536, D = 1024, NPROJ = 3584, DFF = 4096;
constexpr int SEQ_P = 2048, SEQ_S = 8192;
constexpr float EPS = 1e-6f;
constexpr size_t MiB = 1ull << 20;
constexpr size_t WS_WIN = 0, WS_WFO = 7 * MiB, WS_WSO = 9 * MiB, WS_WO = 10 * MiB, WS_WUP = 12 * MiB, WS_WDN = 28 * MiB, WS_WS = 36 * MiB;
constexpr size_t WS_WM = 40 * MiB, WS_Z = 41 * MiB;
constexpr size_t WS_H = 176 * MiB, WS_FM = 176 * MiB;
constexpr size_t WS_FT = 336 * MiB, WS_V = 416 * MiB, WS_U = 496 * MiB, WS_G = 576 * MiB;
constexpr size_t WS_MG = 336 * MiB, WS_O = 576 * MiB, WS_H2 = 40 * MiB, WS_ACT = 200 * MiB, WS_SB = 840 * MiB, WS_FF = 40 * MiB;
constexpr size_t WS_BAR = 976 * MiB;
constexpr size_t WS_SG = 896 * MiB;
constexpr size_t WS_SS1 = 880 * MiB, WS_SS2 = 885 * MiB, WS_END = 977 * MiB;

constexpr int BM = 256, BK = 64, HALF = 128, HTB = HALF * BK * 2, STAGE_BYTES = 8 * HTB, NXCD = 8, WGM = 8;
constexpr int XCH_OFF = STAGE_BYTES, XCH_BYTES = 8192, BAR_ST_OFF = STAGE_BYTES + XCH_BYTES, LDS_BYTES = STAGE_BYTES + XCH_BYTES + 16;

struct Args {
    const float *xp, *xs, *g_pre_mix, *w_in, *ln_g, *ln_b, *w_s, *b_s, *w_fo, *w_so, *w_o, *g_post_mix, *g_pre_ffn, *w_up, *conv_w, *conv_b, *w_down, *g_post_ffn;
    float* out; unsigned char* ws; int ph_lo, ph_hi, p0mask, pad_;
};

__device__ __forceinline__ unsigned cvt_pk_bf16(float lo, float hi) { unsigned r; asm volatile("v_cvt_pk_bf16_f32 %0, %1, %2" : "=v"(r) : "v"(lo), "v"(hi)); return r; }
__device__ __forceinline__ bf16_t f2bf(float x) { return (bf16_t)(cvt_pk_bf16(x, x) & 0xffffu); }
__device__ __forceinline__ float bflo(unsigned u) { return __uint_as_float(u << 16); }
__device__ __forceinline__ float bfhi(unsigned u) { return __uint_as_float(u & 0xffff0000u); }
template <int CTRL> __device__ __forceinline__ float dppx(float x) { return __builtin_bit_cast(float, __builtin_amdgcn_mov_dpp(__builtin_bit_cast(int, x), CTRL, 0xf, 0xf, true)); }
__device__ __forceinline__ float row16_sum(float v) { v += dppx<0xB1>(v); v += dppx<0x4E>(v); v += dppx<0x141>(v); v += dppx<0x128>(v); return v; }
__device__ __forceinline__ float wave_sum(float v) { v = row16_sum(v); v += __shfl_xor(v, 16); v += __shfl_xor(v, 32); return v; }
__device__ __forceinline__ float sigmoid_f(float x) { return __builtin_amdgcn_rcpf(1.0f + __builtin_amdgcn_exp2f(-1.4426950409f * x)); }
__device__ __forceinline__ float gelu_f(float x) {
    const float q = x * __builtin_fmaf(x * x, -0.10294324f, -2.3022082f);
    return x * __builtin_amdgcn_rcpf(1.0f + __builtin_amdgcn_exp2f(q));
}
#define LDS_WAIT() asm volatile("s_waitcnt lgkmcnt(0)" ::: "memory")

__device__ __forceinline__ int lds_byte(int r, int c) { const int st = (r >> 4) * 2 + (c >> 5), rr = r & 15, cc = c & 31, ob = rr * 64 + cc * 2; return st * 1024 + (ob ^ (((ob >> 9) & 1) << 5)); }
__device__ __forceinline__ void stage_rc(int b, int& R, int& C) { const int st = b / 1024, sb = b % 1024, swz = sb ^ (((sb >> 9) & 1) << 5); R = (st >> 1) * 16 + swz / 64; C = (st & 1) * 32 + (swz % 64) / 2; }
__device__ __forceinline__ int perm32(int rho) { const int n = rho >> 4, i = rho & 15; return 8 * (i >> 2) + 4 * n + (i & 3); }

struct Unit { int pm, pn, z; };

struct FlatSched {
    int nM, nN, nwg, G, c; const char *A, *B; size_t tstepA, tstepB;
    __device__ __forceinline__ bool next(int i, Unit& u) const {
        const long L = (long)i * G + c; if (L >= nwg) return false;
        int wgid = (int)L; { const int q = nwg / NXCD, r = nwg % NXCD, xcd = wgid % NXCD, off = wgid / NXCD; wgid = (xcd < r ? xcd * (q + 1) : r * (q + 1) + (xcd - r) * q) + off; }
        const int nig = WGM * nN, gid = wgid / nig, fm = gid * WGM, gsz = (nM - fm) < WGM ? (nM - fm) : WGM;
        u.pm = fm + ((wgid % nig) % gsz); u.pn = (wgid % nig) / gsz; u.z = 0; return true;
    }
    __device__ __forceinline__ const char* aptr(const Unit& u) const { return A + (size_t)u.pm * tstepA; }
    __device__ __forceinline__ const char* bptr(const Unit& u) const { return B + (size_t)u.pn * tstepB; }
};
struct FftSched {
    int c, G; const char *A, *B;
    __device__ __forceinline__ bool next(int i, Unit& u) const {
        const int L = i * G + c; if (L >= 776) return false;
        if (L < 640) { u.z = L / 20; const int r = L % 20; u.pm = r & 1; u.pn = r >> 1; }
        else { const int L2 = L - 640; u.z = 32 + L2 / 68; const int r = L2 % 68; u.pm = r & 1; u.pn = r >> 1; }
        return true;
    }
    __device__ __forceinline__ const char* aptr(const Unit& u) const { return A + (size_t)u.pm * 256 * 512 * 2; }
    __device__ __forceinline__ const char* bptr(const Unit& u) const { const size_t zrow0 = u.z < 32 ? (size_t)u.z * 2560 : (size_t)32 * 2560 + (size_t)(u.z - 32) * 8704; return B + (zrow0 + (size_t)u.pn * 256) * 512 * 2; }
};

template <class E> struct RowPerm { static constexpr bool v = false; };
struct EpiUp; template <> struct RowPerm<EpiUp> { static constexpr bool v = true; };
template <class Epi, class Sched>
__device__ __forceinline__ void gemm_phase(LAS unsigned char* lds, const int K, const int lda, const int ldb, const size_t hstepB, const Sched& S, const Epi& E) {
    const int tid = threadIdx.x, wid = __builtin_amdgcn_readfirstlane(tid >> 6), lane = tid & 63, wr = wid >> 2, wc = wid & 3, fr = lane & 15, fq = lane >> 4;
    const int nt = K / BK;
    unsigned voffA[2], voffB[2];
#pragma unroll
    for (int i = 0; i < 2; ++i) { int R, C; stage_rc(tid * 16 + i * 8192, R, C); const int Rb = (R & ~31) + perm32(R & 31);
        const int Ra = RowPerm<Epi>::v ? ((R & ~63) + 4 * (R & 15) + ((R >> 4) & 3)) : R;
        voffA[i] = (unsigned)(Ra * lda + C) * 2u; voffB[i] = (unsigned)(Rb * ldb + C) * 2u; }
    const size_t kstep = (size_t)(BK * 2);
    const size_t hstepA = (size_t)HALF * lda * 2;
    const unsigned ldsw = (unsigned)wid * 1024u;
    const int aoff = lds_byte(wr * 64 + fr, fq * 8), boff = lds_byte(wc * 32 + fr, fq * 8);
#define PG8_SA(b, h) (((b) * 2 + (h)) * HTB)
#define PG8_SB(b, h) ((4 + (b) * 2 + (h)) * HTB)
#define PG8_STAGE(bufoff, gbase, voff) do { _Pragma("unroll") for (int _i = 0; _i < 2; ++_i) \
        __builtin_amdgcn_global_load_lds((const unsigned*)((const char*)(gbase) + (voff)[_i]), (LAS unsigned*)(lds + (bufoff) + ldsw + _i * 8192), 16, 0, 0); } while (0)
#define PG8_LDA(dst, b, h) do { _Pragma("unroll") for (int m = 0; m < 4; ++m) _Pragma("unroll") for (int k = 0; k < 2; ++k) dst[m][k] = *(const LAS bf16x8*)(lds + PG8_SA(b, h) + aoff + m * 2048 + k * 1024); } while (0)
#define PG8_LDB(dst, b, h) do { _Pragma("unroll") for (int n = 0; n < 2; ++n) _Pragma("unroll") for (int k = 0; k < 2; ++k) dst[n][k] = *(const LAS bf16x8*)(lds + PG8_SB(b, h) + boff + n * 2048 + k * 1024); } while (0)
#define PG8_MMA(ai, bj, At, Bt) do { __builtin_amdgcn_s_setprio(1); _Pragma("unroll") for (int m = 0; m < 4; ++m) _Pragma("unroll") for (int n = 0; n < 2; ++n) _Pragma("unroll") for (int k = 0; k < 2; ++k) \
        acc[ai][bj][m][n] = __builtin_amdgcn_mfma_f32_16x16x32_bf16(Bt[n][k], At[m][k], acc[ai][bj][m][n], 0, 0, 0); __builtin_amdgcn_s_setprio(0); } while (0)
#define PG8_WAIT_V(n) asm volatile("s_waitcnt vmcnt(" #n ")" ::: "memory")
#define PG8_WAIT_L(n) asm volatile("s_waitcnt lgkmcnt(" #n ")" ::: "memory")
#define PG8_BAR __builtin_amdgcn_s_barrier()
#define PG8_SCHED __builtin_amdgcn_sched_barrier(0)
    Unit cur, nxt; int ui = 0;
    if (!S.next(0, cur)) return;
    f32x4 acc[2][2][4][2];
#pragma unroll
    for (int a = 0; a < 2; ++a)
#pragma unroll
        for (int b = 0; b < 2; ++b)
#pragma unroll
            for (int m = 0; m < 4; ++m)
#pragma unroll
                for (int n = 0; n < 2; ++n) acc[a][b][m][n] = (f32x4){0.f, 0.f, 0.f, 0.f};
    bf16x8 At[4][2], B0[2][2], B1[2][2];
    const char* cA = S.aptr(cur); const char* cB = S.bptr(cur);
    PG8_STAGE(PG8_SB(0, 0), cB, voffB); PG8_STAGE(PG8_SB(0, 1), cB + hstepB, voffB); PG8_STAGE(PG8_SA(0, 0), cA, voffA); PG8_STAGE(PG8_SA(0, 1), cA + hstepA, voffA);
    if (wr == 1) PG8_BAR;
    PG8_WAIT_V(2); PG8_BAR;
    PG8_STAGE(PG8_SB(1, 0), cB + kstep, voffB); PG8_STAGE(PG8_SA(1, 0), cA + kstep, voffA); PG8_STAGE(PG8_SB(1, 1), cB + hstepB + kstep, voffB);
    PG8_WAIT_V(6); PG8_BAR;
    for (;;) {
        const bool has_next = S.next(ui + 1, nxt);
        const char* nA = has_next ? S.aptr(nxt) : cA; const char* nB = has_next ? S.bptr(nxt) : cB;
        for (int t = 0; t < nt; t += 2) {
            const bool last = (t == nt - 2);
            const char* a1 = cA + (size_t)(t + 1) * kstep;
            const char* a2 = last ? nA : cA + (size_t)(t + 2) * kstep; const char* b2 = last ? nB : cB + (size_t)(t + 2) * kstep;
            const char* a3 = a2 + kstep; const char* b3 = b2 + kstep;
            PG8_LDB(B0, 0, 0); PG8_LDB(B1, 0, 1); PG8_SCHED; PG8_LDA(At, 0, 0); PG8_STAGE(PG8_SA(1, 1), a1 + hstepA, voffA);
            PG8_WAIT_V(8); PG8_WAIT_L(0); PG8_BAR; PG8_MMA(0, 0, At, B0); PG8_MMA(0, 1, At, B1); PG8_BAR; PG8_SCHED;
            PG8_LDA(At, 0, 1); PG8_STAGE(PG8_SB(0, 0), b2, voffB); PG8_STAGE(PG8_SB(0, 1), b2 + hstepB, voffB); PG8_STAGE(PG8_SA(0, 0), a2, voffA);
            PG8_WAIT_V(8); PG8_WAIT_L(0); PG8_BAR; PG8_MMA(1, 0, At, B0); PG8_MMA(1, 1, At, B1); PG8_BAR; PG8_SCHED;
            PG8_LDB(B0, 1, 0); PG8_LDB(B1, 1, 1); PG8_SCHED; PG8_LDA(At, 1, 0); PG8_STAGE(PG8_SA(0, 1), a2 + hstepA, voffA);
            PG8_WAIT_V(8); PG8_WAIT_L(0); PG8_BAR; PG8_MMA(0, 0, At, B0); PG8_MMA(0, 1, At, B1); PG8_BAR; PG8_SCHED;
            PG8_LDA(At, 1, 1); PG8_STAGE(PG8_SB(1, 0), b3, voffB); PG8_STAGE(PG8_SB(1, 1), b3 + hstepB, voffB); PG8_STAGE(PG8_SA(1, 0), a3, voffA);
            PG8_WAIT_V(8); PG8_WAIT_L(0); PG8_BAR; PG8_MMA(1, 0, At, B0); PG8_MMA(1, 1, At, B1); PG8_BAR; PG8_SCHED;
        }
        if (wr == 0) PG8_BAR;
        E(acc, cur, wr, wc, fr, fq);
        if (!has_next) break;
#pragma unroll
        for (int a = 0; a < 2; ++a)
#pragma unroll
            for (int b = 0; b < 2; ++b)
#pragma unroll
                for (int m = 0; m < 4; ++m)
#pragma unroll
                    for (int n = 0; n < 2; ++n) acc[a][b][m][n] = (f32x4){0.f, 0.f, 0.f, 0.f};
        cur = nxt; cA = nA; cB = nB; ++ui;
        if (wr == 1) PG8_BAR;
    }
    PG8_WAIT_V(0);
    PG8_BAR;
#undef PG8_SA
#undef PG8_SB
#undef PG8_STAGE
#undef PG8_LDA
#undef PG8_LDB
#undef PG8_MMA
#undef PG8_WAIT_V
#undef PG8_WAIT_L
#undef PG8_BAR
#undef PG8_SCHED
}

typedef f32x4 AccT[2][2][4][2];

struct EpiInProj {
    bf16_t* Ft; unsigned char* wsb;
    __device__ __forceinline__ void operator()(const AccT& acc, const Unit& u, int wr, int wc, int fr, int fq) const {
        const int tb = u.pm * BM;
        if (u.pn < 2) {
            int S, ts0; if (tb < TP) { S = SEQ_P; ts0 = tb & ~(SEQ_P - 1); } else { S = SEQ_S; ts0 = TP + ((tb - TP) & ~(SEQ_S - 1)); }
            bf16_t* ft = Ft + (size_t)ts0 * 512 + (tb - ts0 + wr * 64 + fr);
#pragma unroll
            for (int bj = 0; bj < 2; ++bj)
#pragma unroll
                for (int n = 0; n < 2; ++n) { const int c0 = 256 * u.pn + 128 * bj + 32 * wc + 8 * fq + 4 * n;
#pragma unroll
                    for (int j = 0; j < 4; ++j) { bf16_t* cp = ft + (size_t)(c0 + j) * S;
#pragma unroll
                        for (int ai = 0; ai < 2; ++ai)
#pragma unroll
                            for (int m = 0; m < 4; ++m) cp[ai * HALF + m * 16] = f2bf(acc[ai][bj][m][n][j]); } }
        } else {
            const bool sig = u.pn >= 6; const size_t isU = u.pn < 4 ? 1 : 0, isV = (u.pn >= 4 && u.pn < 6) ? 1 : 0;
            bf16_t* base = (bf16_t*)(wsb + WS_G + isU * (WS_U - WS_G) + isV * (WS_V - WS_G));
            const int ldc = sig ? 2048 : 512, colt = sig ? (u.pn - 6) * 256 : ((u.pn - 2) & 1) * 256;
            const int row0 = tb + wr * 64 + fr, col0 = colt + wc * 32 + 8 * fq;
#pragma unroll
            for (int ai = 0; ai < 2; ++ai)
#pragma unroll
                for (int m = 0; m < 4; ++m) { bf16_t* rowp = base + (size_t)(row0 + ai * HALF + m * 16) * ldc + col0;
#pragma unroll
                    for (int bj = 0; bj < 2; ++bj) { f32x4 v0 = acc[ai][bj][m][0], v1 = acc[ai][bj][m][1];
                        if (sig) {
#pragma unroll
                            for (int j = 0; j < 4; ++j) { v0[j] = sigmoid_f(v0[j]); v1[j] = sigmoid_f(v1[j]); }
                        } else {
#pragma unroll
                            for (int j = 0; j < 4; ++j) { v0[j] = gelu_f(v0[j]); v1[j] = gelu_f(v1[j]); }
                        }
                        u32x4 w; w.x = cvt_pk_bf16(v0[0], v0[1]); w.y = cvt_pk_bf16(v0[2], v0[3]); w.z = cvt_pk_bf16(v1[0], v1[1]); w.w = cvt_pk_bf16(v1[2], v1[3]);
                        *(u32x4*)(rowp + bj * HALF) = w; } }
        }
    }
};

struct EpiFft {
    bf16_t* FM;
    __device__ __forceinline__ void operator()(const AccT& acc, const Unit& u, int wr, int wc, int fr, int fq) const {
        int S, N1, tok0; if (u.z < 32) { S = SEQ_P; N1 = 8; tok0 = u.z * SEQ_P; } else { S = SEQ_S; N1 = 32; tok0 = TP + (u.z - 32) * SEQ_S; }
        const int k1 = u.pn >> 1, ch = u.pn & 1, part = u.pm; const bool mirror = k1 > 0 && k1 < (N1 >> 1);
        const int c0 = part * 512 + ch * 256 + 32 * wc + 8 * fq;
#pragma unroll
        for (int ai = 0; ai < 2; ++ai)
#pragma unroll
            for (int m = 0; m < 4; ++m) { const int k2 = ai * HALF + wr * 64 + m * 16 + fr, k = k1 + N1 * k2;
#pragma unroll
                for (int bj = 0; bj < 2; ++bj) { const f32x4 v0 = acc[ai][bj][m][0], v1 = acc[ai][bj][m][1];
                    u32x4 w; w.x = cvt_pk_bf16(v0[0], v0[1]); w.y = cvt_pk_bf16(v0[2], v0[3]); w.z = cvt_pk_bf16(v1[0], v1[1]); w.w = cvt_pk_bf16(v1[2], v1[3]);
                    *(u32x4*)(FM + (size_t)(tok0 + k) * 1024 + c0 + bj * HALF) = w;
                    if (mirror) { if (part) { w.x ^= 0x80008000u; w.y ^= 0x80008000u; w.z ^= 0x80008000u; w.w ^= 0x80008000u; }
                        *(u32x4*)(FM + (size_t)(tok0 + S - k) * 1024 + c0 + bj * HALF) = w; }
                } }
    }
};

template <int MODE> struct EpiMerge {
    bf16_t* Y; const bf16_t* G;
    __device__ __forceinline__ void operator()(const AccT& acc, const Unit& u, int wr, int wc, int fr, int fq) const {
        const int row0 = u.pm * BM + wr * 64 + fr, col0 = u.pn * BM + wc * 32 + 8 * fq;
#pragma unroll
        for (int ai = 0; ai < 2; ++ai)
#pragma unroll
            for (int m = 0; m < 4; ++m) { const size_t row = (size_t)(row0 + ai * HALF + m * 16);
#pragma unroll
                for (int bj = 0; bj < 2; ++bj) { const f32x4 v0 = acc[ai][bj][m][0], v1 = acc[ai][bj][m][1];
                    const u32x4 g = *(const u32x4*)(G + row * 2048 + MODE * 1024 + col0 + bj * HALF);
                    float r[8] = {bflo(g.x) * v0[0], bfhi(g.x) * v0[1], bflo(g.y) * v0[2], bfhi(g.y) * v0[3], bflo(g.z) * v1[0], bfhi(g.z) * v1[1], bflo(g.w) * v1[2], bfhi(g.w) * v1[3]};
                    bf16_t* yp = Y + row * 1024 + col0 + bj * HALF;
                    if (MODE == 1) { const u32x4 y = *(const u32x4*)yp;
                        r[0] += bflo(y.x); r[1] += bfhi(y.x); r[2] += bflo(y.y); r[3] += bfhi(y.y); r[4] += bflo(y.z); r[5] += bfhi(y.z); r[6] += bflo(y.w); r[7] += bfhi(y.w); }
                    u32x4 w; w.x = cvt_pk_bf16(r[0], r[1]); w.y = cvt_pk_bf16(r[2], r[3]); w.z = cvt_pk_bf16(r[4], r[5]); w.w = cvt_pk_bf16(r[6], r[7]);
                    *(u32x4*)yp = w; } }
    }
};

struct EpiRowSS {
    bf16_t* O; float* SSQ;
    __device__ __forceinline__ void operator()(const AccT& acc, const Unit& u, int wr, int wc, int fr, int fq) const {
        const int row0 = u.pm * BM + wr * 64 + fr, col0 = u.pn * BM + wc * 32 + 8 * fq;
#pragma unroll
        for (int ai = 0; ai < 2; ++ai)
#pragma unroll
            for (int m = 0; m < 4; ++m) { const size_t row = (size_t)(row0 + ai * HALF + m * 16); float s = 0.f;
#pragma unroll
                for (int bj = 0; bj < 2; ++bj) { const f32x4 v0 = acc[ai][bj][m][0], v1 = acc[ai][bj][m][1];
                    s += (v0[0] * v0[0] + v0[1] * v0[1]) + (v0[2] * v0[2] + v0[3] * v0[3]) + (v1[0] * v1[0] + v1[1] * v1[1]) + (v1[2] * v1[2] + v1[3] * v1[3]);
                    u32x4 w; w.x = cvt_pk_bf16(v0[0], v0[1]); w.y = cvt_pk_bf16(v0[2], v0[3]); w.z = cvt_pk_bf16(v1[0], v1[1]); w.w = cvt_pk_bf16(v1[2], v1[3]);
                    *(u32x4*)(O + row * 1024 + col0 + bj * HALF) = w; }
                s += __shfl_xor(s, 16); s += __shfl_xor(s, 32);
                if (fq == 0) SSQ[row * 16 + u.pn * 4 + wc] = s; }
    }
};

typedef _Float16 h2_t __attribute__((ext_vector_type(2)));
__device__ __forceinline__ h2_t pk_h2(float a, float b) { return __builtin_bit_cast(h2_t, __builtin_amdgcn_cvt_pkrtz(a, b)); }
template <int CTRL> __device__ __forceinline__ h2_t dpp_h2(h2_t x) { return __builtin_bit_cast(h2_t, __builtin_amdgcn_mov_dpp(__builtin_bit_cast(int, x), CTRL, 0xf, 0xf, true)); }
__device__ __forceinline__ h2_t sel_h2(bool c, h2_t a, h2_t b) { return __builtin_bit_cast(h2_t, c ? __builtin_bit_cast(int, a) : __builtin_bit_cast(int, b)); }
template <int CTRL> __device__ __forceinline__ float dpp_f(float x) { return __builtin_bit_cast(float, __builtin_amdgcn_update_dpp(0, __builtin_bit_cast(int, x), CTRL, 0xf, 0xf, false)); }
struct EpiUp {
    bf16_t* ACT; float* SB; const float *cw, *cb; LAS float* X;
    __device__ __forceinline__ void operator()(const AccT& acc, const Unit& u, int wr, int wc, int fr, int fq) const {
        const int ccb = 32 * wc + 8 * fq;
#pragma unroll
        for (int ai = 0; ai < 2; ++ai) { const int q4 = ai * 2 + wr;
#pragma unroll
            for (int bj = 0; bj < 2; ++bj)
#pragma unroll
                for (int n = 0; n < 2; ++n) {
                    if (fr == 0) *(LAS f32x4*)(X + ((q4 * 2 + 0) * 2 + bj) * 128 + ccb + 4 * n) = acc[ai][bj][0][n];
                    if (fr == 15) *(LAS f32x4*)(X + ((q4 * 2 + 1) * 2 + bj) * 128 + ccb + 4 * n) = acc[ai][bj][3][n];
                    const int scol = bj * 4096 + 128 * u.pn + ccb + 4 * n;
                    if (q4 == 0 && fr == 0) { *(f32x4*)(SB + ((size_t)u.pm * 4 + 0) * 8192 + scol) = acc[ai][bj][0][n]; *(f32x4*)(SB + ((size_t)u.pm * 4 + 1) * 8192 + scol) = acc[ai][bj][1][n]; }
                    if (q4 == 3 && fr == 15) { *(f32x4*)(SB + ((size_t)u.pm * 4 + 2) * 8192 + scol) = acc[ai][bj][2][n]; *(f32x4*)(SB + ((size_t)u.pm * 4 + 3) * 8192 + scol) = acc[ai][bj][3][n]; }
                } }
        LDS_WAIT(); __builtin_amdgcn_s_barrier(); asm volatile("" ::: "memory");
#pragma unroll
        for (int n = 0; n < 2; ++n) {
            const int colg = 128 * u.pn + ccb + 4 * n;
            h2_t w0[2][2], w1[2][2], w2[2][2], bb[2][2];
#pragma unroll
            for (int bj = 0; bj < 2; ++bj) { const int col = bj * 4096 + colg;
                const f32x4 a0 = *(const f32x4*)(cw + col), a1 = *(const f32x4*)(cw + 8192 + col), a2 = *(const f32x4*)(cw + 16384 + col), ab = *(const f32x4*)(cb + col);
                w0[bj][0] = pk_h2(a0[0], a0[1]); w0[bj][1] = pk_h2(a0[2], a0[3]); w1[bj][0] = pk_h2(a1[0], a1[1]); w1[bj][1] = pk_h2(a1[2], a1[3]);
                w2[bj][0] = pk_h2(a2[0], a2[1]); w2[bj][1] = pk_h2(a2[2], a2[3]); bb[bj][0] = pk_h2(ab[0], ab[1]); bb[bj][1] = pk_h2(ab[2], ab[3]); }
            const h2_t C1 = (h2_t){(_Float16)-2.3022082f, (_Float16)-2.3022082f}, C2 = (h2_t){(_Float16)-0.10294324f, (_Float16)-0.10294324f}, ONE = (h2_t){(_Float16)1.0f, (_Float16)1.0f};
#pragma unroll
            for (int ai = 0; ai < 2; ++ai) { const int q4 = ai * 2 + wr;
                h2_t xp[2][2], xn[2][2], ch[2][4][2];
#pragma unroll
                for (int bj = 0; bj < 2; ++bj) {
                    f32x4 fp = (f32x4){0.f, 0.f, 0.f, 0.f}, fn = (f32x4){0.f, 0.f, 0.f, 0.f};
                    if (fr == 15 && q4 > 0) fp = *(const LAS f32x4*)(X + (((q4 - 1) * 2 + 1) * 2 + bj) * 128 + ccb + 4 * n);
                    if (fr == 0 && q4 < 3) fn = *(const LAS f32x4*)(X + (((q4 + 1) * 2 + 0) * 2 + bj) * 128 + ccb + 4 * n);
                    xp[bj][0] = pk_h2(fp[0], fp[1]); xp[bj][1] = pk_h2(fp[2], fp[3]); xn[bj][0] = pk_h2(fn[0], fn[1]); xn[bj][1] = pk_h2(fn[2], fn[3]);
#pragma unroll
                    for (int m = 0; m < 4; ++m) { const f32x4 v = acc[ai][bj][m][n]; ch[bj][m][0] = pk_h2(v[0], v[1]); ch[bj][m][1] = pk_h2(v[2], v[3]); }
                }
#pragma unroll
                for (int m = 0; m < 4; ++m) {
                    unsigned wq[2];
#pragma unroll
                    for (int pr = 0; pr < 2; ++pr) {
                        h2_t up[2];
#pragma unroll
                        for (int bj = 0; bj < 2; ++bj) {
                            const h2_t cur = ch[bj][m][pr];
                            h2_t pv, nv;
                            if (m == 0) pv = dpp_h2<0x121>(sel_h2(fr == 15, xp[bj][pr], ch[bj][3][pr]));
                            else pv = ch[bj][m == 0 ? 0 : m - 1][pr];
                            if (m == 3) nv = dpp_h2<0x12F>(sel_h2(fr == 0, xn[bj][pr], ch[bj][0][pr]));
                            else nv = ch[bj][m == 3 ? 3 : m + 1][pr];
                            h2_t r = __builtin_elementwise_fma(w1[bj][pr], cur, bb[bj][pr]);
                            r = __builtin_elementwise_fma(w0[bj][pr], pv, r);
                            r = __builtin_elementwise_fma(w2[bj][pr], nv, r);
                            up[bj] = r;
                        }
                        const h2_t g = up[0], q = g * __builtin_elementwise_fma(g * g, C2, C1);
                        const h2_t d = __builtin_elementwise_exp2(q) + ONE;
                        h2_t rc; rc.x = __builtin_amdgcn_rcph(d.x); rc.y = __builtin_amdgcn_rcph(d.y);
                        const h2_t o = (g * rc) * up[1];
                        wq[pr] = cvt_pk_bf16((float)o.x, (float)o.y);
                    }
                    u32x2 w; w.x = wq[0]; w.y = wq[1];
                    const size_t row = (size_t)(u.pm * BM + ai * HALF + wr * 64 + 4 * fr + m);
                    *(u32x2*)(ACT + row * DFF + colg) = w;
                } }
        }
    }
};

__device__ __forceinline__ void p0_transpose_item(const float* W, int K, int N, bf16_t* WT, LAS float* scr, int item, int lane) {
    const int nblk = N / 32, kb = item / nblk, nb = item % nblk, k0 = 64 * kb, n0 = 32 * nb;
#pragma unroll
    for (int i = 0; i < 32; ++i) { const int kk = 2 * i + (lane >> 5); scr[kk * 33 + (lane & 31)] = W[(size_t)(k0 + kk) * N + n0 + (lane & 31)]; }
    LDS_WAIT(); asm volatile("" ::: "memory");
    const int c = lane & 7;
#pragma unroll
    for (int j = 0; j < 4; ++j) { const int n = (lane >> 3) + 8 * j; const LAS float* s = scr + (8 * c) * 33 + n;
        u32x4 o; o.x = cvt_pk_bf16(s[0 * 33], s[1 * 33]); o.y = cvt_pk_bf16(s[2 * 33], s[3 * 33]); o.z = cvt_pk_bf16(s[4 * 33], s[5 * 33]); o.w = cvt_pk_bf16(s[6 * 33], s[7 * 33]);
        *(u32x4*)(WT + (size_t)(n0 + n) * K + k0 + 8 * c) = o; }
    LDS_WAIT(); asm volatile("" ::: "memory");
}

__device__ __forceinline__ void phase_prep(const Args& a, LAS unsigned char* lds) {
    const int tid = threadIdx.x, lane = tid & 63, wave = tid >> 6, G = gridDim.x;
    const bool prepw = wave < 2;
    const int gw = blockIdx.x * 2 + wave, NGW = G * 2;
    const size_t gt = (size_t)blockIdx.x * 128 + tid, NGT = (size_t)G * 128;
    const int hw = blockIdx.x * 6 + (wave - 2), NHW = G * 6;
    unsigned char* ws = a.ws;
    LAS float* scr = (LAS float*)(lds + wave * 8448);
    LAS float* tb128 = (LAS float*)(lds + 67584);
    if (tid < 128) tb128[tid] = cospif((float)tid * (1.0f / 64.0f));
    __syncthreads();
    if (prepw && (a.p0mask & 1)) {
        constexpr int I_IN = (D / 64) * (NPROJ / 32), I_SO = (512 / 64) * (D / 32), I_O = (D / 64) * (D / 32), I_UP = (D / 64) * (2 * DFF / 32), I_DN = (DFF / 64) * (D / 32);
        constexpr int NIT = I_IN + I_SO + I_O;
        (void)I_UP; (void)I_DN;
        for (int it = gw; it < NIT; it += NGW) {
            int r = it;
            if (r < I_IN) { p0_transpose_item(a.w_in, D, NPROJ, (bf16_t*)(ws + WS_WIN), scr, r, lane); continue; } r -= I_IN;
            if (r < I_SO) { p0_transpose_item(a.w_so, 512, D, (bf16_t*)(ws + WS_WSO), scr, r, lane); continue; } r -= I_SO;
            p0_transpose_item(a.w_o, D, D, (bf16_t*)(ws + WS_WO), scr, r, lane);
        }
    }
    if (prepw && (a.p0mask & 2)) {
        bf16_t* wfo = (bf16_t*)(ws + WS_WFO);
        for (int un = blockIdx.x + G * wave; un < 512; un += G * 2) {
            const int db = un & 3, cb = (un >> 2) & 15, cs = (un >> 6) & 1, g = un >> 7, d0 = db * 256 + lane * 4, c0 = cb * 8;
            const float* wp = a.w_fo + (size_t)(g * 128) * 1024 + d0;
            f32x4 acc[8];
#pragma unroll
            for (int e = 0; e < 8; ++e) acc[e] = (f32x4){0.f, 0.f, 0.f, 0.f};
#pragma unroll 8
            for (int l = 0; l < 128; ++l) { const f32x4 w = *(const f32x4*)(wp + (size_t)l * 1024);
#pragma unroll
                for (int e = 0; e < 8; ++e) { const int ph = (l * (c0 + e)) & 127; const float cf = cs ? -tb128[(ph - 32) & 127] : tb128[ph]; acc[e] += cf * w; } }
            const float sc = 0.08838834764831845f;
#pragma unroll
            for (int j = 0; j < 4; ++j) { u32x4 o; o.x = cvt_pk_bf16(acc[0][j] * sc, acc[1][j] * sc); o.y = cvt_pk_bf16(acc[2][j] * sc, acc[3][j] * sc); o.z = cvt_pk_bf16(acc[4][j] * sc, acc[5][j] * sc); o.w = cvt_pk_bf16(acc[6][j] * sc, acc[7][j] * sc);
                *(u32x4*)(wfo + (size_t)(d0 + j) * 1024 + cs * 512 + g * 128 + c0) = o; }
        }
    }
    if (prepw && (a.p0mask & 4)) {
        bf16_t* wm = (bf16_t*)(ws + WS_WM);
        for (size_t idx = gt; idx < (size_t)512 * 512; idx += NGT) {
            const int m = (int)(idx >> 9), kk = (int)(idx & 511), mm = m & 255, s2 = kk & 255;
            const float rev = (float)((mm * s2) & 255) * (1.0f / 256.0f), cv = __builtin_amdgcn_cosf(rev), sv = __builtin_amdgcn_sinf(rev);
            const float v = (m < 256) ? (kk < 256 ? cv : sv) : (kk < 256 ? sv : -cv);
            wm[idx] = f2bf(v);
        }
    }
    if (prepw && (a.p0mask & 8)) {
        bf16_t* wsb = (bf16_t*)(ws + WS_WS);
        for (size_t idx = gt; idx < 65536; idx += NGT) wsb[idx] = f2bf(a.w_s[idx]);
    }
    if (a.p0mask & 16) {
        bf16_t* H = (bf16_t*)(ws + WS_H);
        f32x4 gv[4];
#pragma unroll
        for (int j = 0; j < 4; ++j) gv[j] = *(const f32x4*)(a.g_pre_mix + 4 * lane + 256 * j);
        constexpr int R_H = 69632;
        for (int row0 = prepw ? R_H + gw * 4 : hw * 4; row0 < (prepw ? T : R_H); row0 += (prepw ? NGW : NHW) * 4) {
            f32x4 v[4][4]; float s[4];
#pragma unroll
            for (int rr = 0; rr < 4; ++rr) { const int row = row0 + rr; const float* xr = row < TP ? a.xp + (size_t)row * D : a.xs + (size_t)(row - TP) * D;
#pragma unroll
                for (int j = 0; j < 4; ++j) v[rr][j] = *(const f32x4*)(xr + 4 * lane + 256 * j); }
#pragma unroll
            for (int rr = 0; rr < 4; ++rr) { float t = 0.f;
#pragma unroll
                for (int j = 0; j < 4; ++j) t += (v[rr][j][0] * v[rr][j][0] + v[rr][j][1] * v[rr][j][1]) + (v[rr][j][2] * v[rr][j][2] + v[rr][j][3] * v[rr][j][3]);
                s[rr] = t; }
#pragma unroll
            for (int rr = 0; rr < 4; ++rr) s[rr] = wave_sum(s[rr]);
#pragma unroll
            for (int rr = 0; rr < 4; ++rr) { const float r = rsqrtf(s[rr] * (1.0f / D) + EPS);
#pragma unroll
                for (int j = 0; j < 4; ++j) { u32x2 o; o.x = cvt_pk_bf16(v[rr][j][0] * r * gv[j][0], v[rr][j][1] * r * gv[j][1]); o.y = cvt_pk_bf16(v[rr][j][2] * r * gv[j][2], v[rr][j][3] * r * gv[j][3]);
                    *(u32x2*)(H + (size_t)(row0 + rr) * D + 4 * lane + 256 * j) = o; } }
        }
    }
}

template <int N1, int VPL> __device__ __forceinline__ void fftpre_load(const bf16_t* ft, int S, int c, int s2, float (&x)[N1][VPL]) {
#pragma unroll
    for (int s1 = 0; s1 < N1; ++s1) {
        const bf16_t* p = ft + (size_t)c * S + 256 * s1 + s2;
        if (VPL == 4) { const u32x2 r = *(const u32x2*)p; x[s1][0] = bflo(r.x); x[s1][1] = bfhi(r.x); x[s1][2 % VPL] = bflo(r.y); x[s1][3 % VPL] = bfhi(r.y); }
        else { const unsigned r = *(const unsigned*)p; x[s1][0] = bflo(r); x[s1][1] = bfhi(r); }
    }
}
template <int N1, int VPL> __device__ __forceinline__ void fftpre_compute(const float (&x)[N1][VPL], bf16_t* zb, int S, int c, int s2, const LAS float* tb, float scale) {
#pragma unroll 1
    for (int k1 = 0; k1 <= N1 / 2; ++k1) {
        float yr[VPL], yi[VPL];
#pragma unroll
        for (int v = 0; v < VPL; ++v) { yr[v] = 0.f; yi[v] = 0.f; }
#pragma unroll
        for (int s1 = 0; s1 < N1; ++s1) { const int id = ((k1 * s1) & (N1 - 1)) * (32 / N1); const float cr = tb[id], sr = tb[(id - 8) & 31];
#pragma unroll
            for (int v = 0; v < VPL; ++v) { yr[v] += x[s1][v] * cr; yi[v] -= x[s1][v] * sr; } }
        float tr[VPL], ti[VPL];
#pragma unroll
        for (int v = 0; v < VPL; ++v) { const float rev = (float)(k1 * (s2 + v)) / (float)S, wr = __builtin_amdgcn_cosf(rev), wi = -__builtin_amdgcn_sinf(rev);
            tr[v] = (yr[v] * wr - yi[v] * wi) * scale; ti[v] = (yr[v] * wi + yi[v] * wr) * scale; }
        bf16_t* zr = zb + ((size_t)k1 * 512 + c) * 512 + s2;
        if (VPL == 4) { u32x2 o; o.x = cvt_pk_bf16(tr[0], tr[1]); o.y = cvt_pk_bf16(tr[2 % VPL], tr[3 % VPL]); *(u32x2*)zr = o; o.x = cvt_pk_bf16(ti[0], ti[1]); o.y = cvt_pk_bf16(ti[2 % VPL], ti[3 % VPL]); *(u32x2*)(zr + 256) = o; }
        else { *(unsigned*)zr = cvt_pk_bf16(tr[0], tr[1]); *(unsigned*)(zr + 256) = cvt_pk_bf16(ti[0], ti[1]); }
    }
}
__device__ __forceinline__ void phase_fftpre(const Args& a, LAS unsigned char* lds) {
    const int tid = threadIdx.x, lane = tid & 63, wave = tid >> 6;
    const int gw = blockIdx.x * 8 + wave, NGW = gridDim.x * 8;
    LAS float* tb = (LAS float*)(lds + XCH_OFF);
    if (tid < 32) tb[tid] = cospif((float)tid * (1.0f / 16.0f));
    __syncthreads();
    const bf16_t* Ft = (const bf16_t*)(a.ws + WS_FT); bf16_t* Z = (bf16_t*)(a.ws + WS_Z);
    constexpr float SCP = 0.022097086912079608f, SCS = 0.011048543456039806f;
    {
        float xa[8][4], xb[8][4]; const int s2 = lane * 4;
        int base, cnt, stride;
        if (gridDim.x == 256) { stride = 1024; if (blockIdx.x < 128) { base = blockIdx.x * 8 + wave; cnt = 5; } else { base = 5120 + (blockIdx.x - 128) * 8 + wave; cnt = 11; } }
        else { stride = NGW; base = gw; cnt = (16384 - gw + NGW - 1) / NGW; }
#define FP_LOAD(k, X) do { const int it_ = base + stride * (k); fftpre_load<8, 4>(Ft + (size_t)(it_ >> 9) * SEQ_P * 512, SEQ_P, it_ & 511, s2, X); } while (0)
#define FP_COMP(k, X) do { const int it_ = base + stride * (k); fftpre_compute<8, 4>(X, Z + (size_t)(it_ >> 9) * 2560 * 512, SEQ_P, it_ & 511, s2, tb, SCP); } while (0)
        if (cnt > 0) FP_LOAD(0, xa);
        for (int k = 0; k < cnt; k += 2) {
            if (k + 1 < cnt) FP_LOAD(k + 1, xb);
            FP_COMP(k, xa);
            if (k + 2 < cnt) FP_LOAD(k + 2, xa);
            if (k + 1 < cnt) FP_COMP(k + 1, xb);
        }
#undef FP_LOAD
#undef FP_COMP
    }
    for (int j = gw; j < 2048; j += NGW) { const int z = j >> 10, c = (j >> 1) & 511, s2 = (j & 1) * 128 + lane * 2;
        float xs[32][2];
        fftpre_load<32, 2>(Ft + ((size_t)TP + (size_t)z * SEQ_S) * 512, SEQ_S, c, s2, xs);
        fftpre_compute<32, 2>(xs, Z + ((size_t)32 * 2560 + (size_t)z * 8704) * 512, SEQ_S, c, s2, tb, SCS); }
}

__device__ __forceinline__ int sgu_swz(int c) { return (c ^ (c >> 4)) & 15; }
__device__ __forceinline__ void phase_sgu(const Args& a, LAS unsigned char* lds) {
    const int tid = threadIdx.x, lane = tid & 63, wave = tid >> 6, fr = lane & 15, fq = lane >> 4;
    const bf16_t* V = (const bf16_t*)(a.ws + WS_V); const bf16_t* U = (const bf16_t*)(a.ws + WS_U); bf16_t* SG = (bf16_t*)(a.ws + WS_SG); const bf16_t* WS = (const bf16_t*)(a.ws + WS_WS);
    float lg[8], lb[8];
#pragma unroll
    for (int e = 0; e < 8; ++e) { lg[e] = a.ln_g[lane * 8 + e]; lb[e] = a.ln_b[lane * 8 + e]; }
    for (int item = blockIdx.x; item < T / 128; item += gridDim.x) {
        const int t0 = item * 128;
        __syncthreads();
#pragma unroll
        for (int qb = 0; qb < 2; ++qb) {
            u32x4 raw[8]; float x[8][8], s[8], s2[8];
#pragma unroll
            for (int qq = 0; qq < 8; ++qq) raw[qq] = *(const u32x4*)(V + (size_t)(t0 + wave * 16 + qb * 8 + qq) * 512 + lane * 8);
#pragma unroll
            for (int qq = 0; qq < 8; ++qq) { const u32x4 r = raw[qq];
                x[qq][0] = bflo(r.x); x[qq][1] = bfhi(r.x); x[qq][2] = bflo(r.y); x[qq][3] = bfhi(r.y); x[qq][4] = bflo(r.z); x[qq][5] = bfhi(r.z); x[qq][6] = bflo(r.w); x[qq][7] = bfhi(r.w);
                s[qq] = ((x[qq][0] + x[qq][1]) + (x[qq][2] + x[qq][3])) + ((x[qq][4] + x[qq][5]) + (x[qq][6] + x[qq][7])); }
#pragma unroll
            for (int qq = 0; qq < 8; ++qq) s[qq] = row16_sum(s[qq]);
#pragma unroll
            for (int o = 16; o < 64; o <<= 1) {
#pragma unroll
                for (int qq = 0; qq < 8; ++qq) s[qq] += __shfl_xor(s[qq], o); }
#pragma unroll
            for (int qq = 0; qq < 8; ++qq) { const float mu = s[qq] * (1.0f / 512.0f); float t = 0.f;
#pragma unroll
                for (int e = 0; e < 8; ++e) { x[qq][e] -= mu; t += x[qq][e] * x[qq][e]; }
                s2[qq] = t; }
#pragma unroll
            for (int qq = 0; qq < 8; ++qq) s2[qq] = row16_sum(s2[qq]);
#pragma unroll
            for (int o = 16; o < 64; o <<= 1) {
#pragma unroll
                for (int qq = 0; qq < 8; ++qq) s2[qq] += __shfl_xor(s2[qq], o); }
#pragma unroll
            for (int qq = 0; qq < 8; ++qq) s2[qq] = rsqrtf(s2[qq] * (1.0f / 512.0f) + EPS);
#pragma unroll
            for (int e = 0; e < 8; ++e) { const int c = 8 * (lane & 15) + e;
                u32x4 w;
                w.x = cvt_pk_bf16(x[0][e] * s2[0] * lg[e] + lb[e], x[1][e] * s2[1] * lg[e] + lb[e]); w.y = cvt_pk_bf16(x[2][e] * s2[2] * lg[e] + lb[e], x[3][e] * s2[3] * lg[e] + lb[e]);
                w.z = cvt_pk_bf16(x[4][e] * s2[4] * lg[e] + lb[e], x[5][e] * s2[5] * lg[e] + lb[e]); w.w = cvt_pk_bf16(x[6][e] * s2[6] * lg[e] + lb[e], x[7][e] * s2[7] * lg[e] + lb[e]);
                *(LAS u32x4*)(lds + (lane >> 4) * 32768 + c * 256 + (((wave * 2 + qb) ^ sgu_swz(c)) << 4)) = w; }
        }
        __syncthreads();
        const int p = wave * 16 + fr;
#pragma unroll 1
        for (int hh = 0; hh < 4; ++hh) {
            f32x4 acc[8]; bf16x8 af[4]; u32x2 uu[8];
#pragma unroll
            for (int kk = 0; kk < 4; ++kk) af[kk] = *(const bf16x8*)(WS + (size_t)(hh * 128 + p) * 128 + kk * 32 + fq * 8);
#pragma unroll
            for (int nt = 0; nt < 8; ++nt) uu[nt] = *(const u32x2*)(U + (size_t)(t0 + p) * 512 + hh * 128 + nt * 16 + 4 * fq);
            const float bs = a.b_s[hh * 128 + p];
#pragma unroll
            for (int nt = 0; nt < 8; ++nt) acc[nt] = (f32x4){0.f, 0.f, 0.f, 0.f};
#pragma unroll
            for (int kk = 0; kk < 4; ++kk) {
#pragma unroll
                for (int nt = 0; nt < 8; ++nt) { const int c = nt * 16 + fr;
                    const bf16x8 bfm = *(const LAS bf16x8*)(lds + hh * 32768 + c * 256 + (((kk * 4 + fq) ^ sgu_swz(c)) << 4));
                    acc[nt] = __builtin_amdgcn_mfma_f32_16x16x32_bf16(bfm, af[kk], acc[nt], 0, 0, 0); }
            }
#pragma unroll
            for (int nt = 0; nt < 8; ++nt) { u32x2 o;
                o.x = cvt_pk_bf16(bflo(uu[nt].x) * (acc[nt][0] + bs), bfhi(uu[nt].x) * (acc[nt][1] + bs)); o.y = cvt_pk_bf16(bflo(uu[nt].y) * (acc[nt][2] + bs), bfhi(uu[nt].y) * (acc[nt][3] + bs));
                *(u32x2*)(SG + (size_t)(t0 + p) * 512 + hh * 128 + nt * 16 + 4 * fq) = o; }
        }
    }
}

__device__ __forceinline__ void phase_mid(const Args& a) {
    const int tid = threadIdx.x, lane = tid & 63, wave = tid >> 6;
    const int gw = blockIdx.x * 8 + wave, NGW = gridDim.x * 8;
    const bf16_t* O = (const bf16_t*)(a.ws + WS_O); const float* SS = (const float*)(a.ws + WS_SS1); bf16_t* H2 = (bf16_t*)(a.ws + WS_H2);
    f32x4 g1[4], g2[4];
#pragma unroll
    for (int j = 0; j < 4; ++j) { g1[j] = *(const f32x4*)(a.g_post_mix + 4 * lane + 256 * j); g2[j] = *(const f32x4*)(a.g_pre_ffn + 4 * lane + 256 * j); }
    for (int row0 = gw * 4; row0 < T; row0 += NGW * 4) {
        f32x4 v[4][4]; u32x2 ob[4][4]; float ss[4], s2[4];
#pragma unroll
        for (int rr = 0; rr < 4; ++rr) { const int row = row0 + rr; const float* xr = row < TP ? a.xp + (size_t)row * D : a.xs + (size_t)(row - TP) * D;
            ss[rr] = lane < 16 ? SS[(size_t)row * 16 + lane] : 0.f;
#pragma unroll
            for (int j = 0; j < 4; ++j) { v[rr][j] = *(const f32x4*)(xr + 4 * lane + 256 * j); ob[rr][j] = *(const u32x2*)(O + (size_t)row * D + 4 * lane + 256 * j); } }
#pragma unroll
        for (int rr = 0; rr < 4; ++rr) ss[rr] = row16_sum(ss[rr]);
#pragma unroll
        for (int rr = 0; rr < 4; ++rr) { const float r1 = rsqrtf(__shfl(ss[rr], 0) * (1.0f / D) + EPS); float t = 0.f;
#pragma unroll
            for (int j = 0; j < 4; ++j) { const u32x2 o = ob[rr][j];
                v[rr][j][0] += bflo(o.x) * r1 * g1[j][0]; v[rr][j][1] += bfhi(o.x) * r1 * g1[j][1]; v[rr][j][2] += bflo(o.y) * r1 * g1[j][2]; v[rr][j][3] += bfhi(o.y) * r1 * g1[j][3];
                t += (v[rr][j][0] * v[rr][j][0] + v[rr][j][1] * v[rr][j][1]) + (v[rr][j][2] * v[rr][j][2] + v[rr][j][3] * v[rr][j][3]); }
            s2[rr] = t; }
#pragma unroll
        for (int rr = 0; rr < 4; ++rr) s2[rr] = wave_sum(s2[rr]);
#pragma unroll
        for (int rr = 0; rr < 4; ++rr) { const float r2 = rsqrtf(s2[rr] * (1.0f / D) + EPS);
#pragma unroll
            for (int j = 0; j < 4; ++j) { *(f32x4*)(a.out + (size_t)(row0 + rr) * D + 4 * lane + 256 * j) = v[rr][j];
                u32x2 o; o.x = cvt_pk_bf16(v[rr][j][0] * r2 * g2[j][0], v[rr][j][1] * r2 * g2[j][1]); o.y = cvt_pk_bf16(v[rr][j][2] * r2 * g2[j][2], v[rr][j][3] * r2 * g2[j][3]);
                *(u32x2*)(H2 + (size_t)(row0 + rr) * D + 4 * lane + 256 * j) = o; } }
    }
}

__device__ __forceinline__ void fix_panel(const Args& a, int pm) {
    const float* SB = (const float*)(a.ws + WS_SB); bf16_t* ACT = (bf16_t*)(a.ws + WS_ACT);
    for (int idx = threadIdx.x; idx < 2 * 1024; idx += 512) {
        const int f = (idx & 1023) * 4, sd = idx >> 10;
        const int t = pm * 256 + (sd ? 255 : 0);
        bool edge;
        if (sd == 0) edge = t < TP ? ((t & (SEQ_P - 1)) == 0) : (((t - TP) & (SEQ_S - 1)) == 0);
        else edge = t < TP ? (((t + 1) & (SEQ_P - 1)) == 0) : (((t + 1 - TP) & (SEQ_S - 1)) == 0);
        float upv[2][4];
#pragma unroll
        for (int hh = 0; hh < 2; ++hh) { const int col = hh * 4096 + f;
            f32x4 pv = (f32x4){0.f, 0.f, 0.f, 0.f}, nv = (f32x4){0.f, 0.f, 0.f, 0.f}, cv;
            if (sd == 0) { cv = *(const f32x4*)(SB + ((size_t)pm * 4 + 0) * 8192 + col); nv = *(const f32x4*)(SB + ((size_t)pm * 4 + 1) * 8192 + col);
                if (!edge) pv = *(const f32x4*)(SB + ((size_t)(pm - 1) * 4 + 3) * 8192 + col); }
            else { cv = *(const f32x4*)(SB + ((size_t)pm * 4 + 3) * 8192 + col); pv = *(const f32x4*)(SB + ((size_t)pm * 4 + 2) * 8192 + col);
                if (!edge) nv = *(const f32x4*)(SB + ((size_t)(pm + 1) * 4 + 0) * 8192 + col); }
            const f32x4 w0 = *(const f32x4*)(a.conv_w + col), w1 = *(const f32x4*)(a.conv_w + 8192 + col), w2 = *(const f32x4*)(a.conv_w + 16384 + col), bb = *(const f32x4*)(a.conv_b + col);
#pragma unroll
            for (int j = 0; j < 4; ++j) upv[hh][j] = w0[j] * pv[j] + w1[j] * cv[j] + w2[j] * nv[j] + bb[j]; }
        u32x2 w; w.x = cvt_pk_bf16(gelu_f(upv[0][0]) * upv[1][0], gelu_f(upv[0][1]) * upv[1][1]); w.y = cvt_pk_bf16(gelu_f(upv[0][2]) * upv[1][2], gelu_f(upv[0][3]) * upv[1][3]);
        *(u32x2*)(ACT + (size_t)t * DFF + f) = w;
    }
}

__device__ __forceinline__ void phase_final(const Args& a) {
    const int tid = threadIdx.x, lane = tid & 63, wave = tid >> 6;
    const int gw = blockIdx.x * 8 + wave, NGW = gridDim.x * 8;
    const bf16_t* FF = (const bf16_t*)(a.ws + WS_FF); const float* SS = (const float*)(a.ws + WS_SS2);
    f32x4 g1[4];
#pragma unroll
    for (int j = 0; j < 4; ++j) g1[j] = *(const f32x4*)(a.g_post_ffn + 4 * lane + 256 * j);
    for (int row0 = gw * 4; row0 < T; row0 += NGW * 4) {
        f32x4 v[4][4]; u32x2 ob[4][4]; float ss[4];
#pragma unroll
        for (int rr = 0; rr < 4; ++rr) { const int row = row0 + rr;
            ss[rr] = lane < 16 ? SS[(size_t)row * 16 + lane] : 0.f;
#pragma unroll
            for (int j = 0; j < 4; ++j) { v[rr][j] = *(const f32x4*)(a.out + (size_t)row * D + 4 * lane + 256 * j); ob[rr][j] = *(const u32x2*)(FF + (size_t)row * D + 4 * lane + 256 * j); } }
#pragma unroll
        for (int rr = 0; rr < 4; ++rr) ss[rr] = row16_sum(ss[rr]);
#pragma unroll
        for (int rr = 0; rr < 4; ++rr) { const float r1 = rsqrtf(__shfl(ss[rr], 0) * (1.0f / D) + EPS);
#pragma unroll
            for (int j = 0; j < 4; ++j) { const u32x2 o = ob[rr][j]; f32x4 x = v[rr][j];
                x[0] += bflo(o.x) * r1 * g1[j][0]; x[1] += bfhi(o.x) * r1 * g1[j][1]; x[2] += bflo(o.y) * r1 * g1[j][2]; x[3] += bfhi(o.y) * r1 * g1[j][3];
                *(f32x4*)(a.out + (size_t)(row0 + rr) * D + 4 * lane + 256 * j) = x; } }
    }
}

__device__ __forceinline__ void late_transposes(const Args& a, LAS unsigned char* lds, int widx, int wcount) {
    const int lane = threadIdx.x & 63, wave = threadIdx.x >> 6;
    LAS float* scr = (LAS float*)(lds + wave * 8448);
    constexpr int I_UP = (D / 64) * (2 * DFF / 32), I_DN = (DFF / 64) * (D / 32);
    for (int it = widx; it < I_UP + I_DN; it += wcount) {
        if (it < I_UP) p0_transpose_item(a.w_up, D, 2 * DFF, (bf16_t*)(a.ws + WS_WUP), scr, it, lane);
        else p0_transpose_item(a.w_down, DFF, D, (bf16_t*)(a.ws + WS_WDN), scr, it - I_UP, lane);
    }
}

#define XB_TMO      128
#define XB_XCNT(j)  (256  + 64 * (j))
#define XB_XSUB(j)  (1280 + 64 * (j))
#define XB_XGEN(j)  (2304 + 64 * (j))
#define XB_TOP      3328
#define XB_TOPGEN   3392
#define XCD_BAR_WORDS 3456
#define XB_SPIN_CAP (1u << 18)
__device__ __forceinline__ unsigned xb_ld(unsigned* p)              { return __hip_atomic_load(p, __ATOMIC_RELAXED, __HIP_MEMORY_SCOPE_AGENT); }
__device__ __forceinline__ unsigned xb_add(unsigned* p, unsigned v) { return __hip_atomic_fetch_add(p, v, __ATOMIC_RELAXED, __HIP_MEMORY_SCOPE_AGENT); }
__device__ __forceinline__ unsigned xb_xcc_id() { return (unsigned)__builtin_amdgcn_s_getreg((3 << 11) | 20) & 0xFu; }
#define XB_SPIN(cond, bar) do { unsigned _sp = 0; while (cond) { __builtin_amdgcn_s_sleep(1); \
    if ((++_sp & 255u) == 0u) { if (xb_ld(&(bar)[XB_TMO])) break; if (_sp > XB_SPIN_CAP) { atomicAdd(&(bar)[XB_TMO], 1u); break; } } } } while (0)
struct XcdBarrier { unsigned* bar; unsigned x; volatile LAS unsigned* st; };
__device__ __forceinline__ XcdBarrier xcd_barrier_post(unsigned* bar, volatile LAS unsigned* st) {
    XcdBarrier b; b.bar = bar; b.x = xb_xcc_id(); b.st = st;
    if (threadIdx.x == 0) (void)xb_add(&bar[XB_XCNT(b.x)], 1u);
    return b;
}
__device__ __forceinline__ void xcd_barrier_complete(unsigned* bar, unsigned x, unsigned& nloc, unsigned& nx) {
    const unsigned G = gridDim.x * gridDim.y * gridDim.z;
    unsigned sum, cnt, mine, sp = 0u;
    for (;;) {
        sum = 0u; cnt = 0u; mine = 0u;
#pragma unroll
        for (unsigned j = 0; j < 16; ++j) { const unsigned c = xb_ld(&bar[XB_XCNT(j)]); sum += c; cnt += (c > 0u) ? 1u : 0u; mine = (j == x) ? c : mine; }
        if (sum == G) break;
        __builtin_amdgcn_s_sleep(1);
        if ((++sp & 255u) == 0u) { if (xb_ld(&bar[XB_TMO])) break; if (sp > XB_SPIN_CAP) { atomicAdd(&bar[XB_TMO], 1u); break; } }
    }
    nloc = mine > 0u ? mine : 1u; nx = cnt > 0u ? cnt : 1u;
}
__device__ __forceinline__ void xcd_barrier(const XcdBarrier& b) {
    asm volatile("s_waitcnt vmcnt(0)" ::: "memory");
    __syncthreads();
    if (threadIdx.x == 0) {
        unsigned* bar = b.bar;
        __builtin_amdgcn_s_waitcnt(0);
        unsigned nloc = b.st[0], nx = b.st[1];
        if (nloc == 0u) { xcd_barrier_complete(bar, b.x, nloc, nx); b.st[0] = nloc; b.st[1] = nx; }
        const unsigned old = xb_add(&bar[XB_XSUB(b.x)], 1u);
        const unsigned gen = old / nloc;
        if (old + 1u == (gen + 1u) * nloc) {
            __builtin_amdgcn_fence(__ATOMIC_RELEASE, "agent");
            asm volatile("s_waitcnt vmcnt(0)" ::: "memory");
            const unsigned og = xb_add(&bar[XB_TOP], 1u);
            const unsigned tg = og / nx;
            if (og + 1u == (tg + 1u) * nx) xb_add(&bar[XB_TOPGEN], 1u);
            else XB_SPIN(xb_ld(&bar[XB_TOPGEN]) == tg, bar);
            __builtin_amdgcn_fence(__ATOMIC_ACQUIRE, "agent");
            xb_add(&bar[XB_XGEN(b.x)], 1u);
            asm volatile("s_waitcnt vmcnt(0)" ::: "memory");
        } else {
            XB_SPIN(xb_ld(&bar[XB_XGEN(b.x)]) == gen, bar);
            __builtin_amdgcn_fence(__ATOMIC_ACQUIRE, "agent");
            asm volatile("s_waitcnt vmcnt(0)" ::: "memory");
        }
    }
    __syncthreads();
}

constexpr int NPHASE = 10;
__global__ void __launch_bounds__(512) fwd_kernel(Args a) {
    extern __shared__ __attribute__((aligned(16))) unsigned char smem[];
    LAS unsigned char* lds = (LAS unsigned char*)smem;
    unsigned char* ws = a.ws;
    const int G = gridDim.x, c = blockIdx.x;
#ifndef PH_MASK
#define PH_MASK 0x3ff
#endif
#define IN(p) (((PH_MASK >> (p)) & 1) && a.ph_lo <= (p) && (p) < a.ph_hi)
    volatile LAS unsigned* bst = (volatile LAS unsigned*)(lds + BAR_ST_OFF);
    const bool multi = (a.ph_lo == 0 && a.ph_hi == NPHASE);
    XcdBarrier xb; xb.bar = (unsigned*)(ws + WS_BAR); xb.x = 0; xb.st = bst;
    if (multi) {
        if (threadIdx.x < 2) bst[threadIdx.x] = 0u;
        if (blockIdx.x == 0) for (int i = threadIdx.x; i < XCD_BAR_WORDS; i += 512) (void)__hip_atomic_exchange((unsigned*)(ws + WS_BAR) + i, 0u, __ATOMIC_RELAXED, __HIP_MEMORY_SCOPE_AGENT);
        __syncthreads();
    }
#define SEAM(p) do { if (IN(p) && IN((p) + 1)) { if ((p) == 0 || !multi) cg::this_grid().sync(); else xcd_barrier(xb); } } while (0)
    if (IN(0)) phase_prep(a, lds);
    SEAM(0);
    if (multi) xb = xcd_barrier_post((unsigned*)(ws + WS_BAR), bst);
    if (IN(1)) {
        FlatSched S; S.nM = T / 256; S.nN = NPROJ / 256; S.nwg = S.nM * S.nN; S.G = G; S.c = c; S.A = (const char*)(ws + WS_H); S.B = (const char*)(ws + WS_WIN); S.tstepA = 256 * D * 2; S.tstepB = 256 * D * 2;
        EpiInProj E; E.Ft = (bf16_t*)(ws + WS_FT); E.wsb = ws;
        gemm_phase(lds, D, D, D, (size_t)HALF * D * 2, S, E);
        { const int rem = S.nwg % G, nshort = rem ? G - rem : G;
          if (c >= (rem ? rem : 0)) late_transposes(a, lds, (c - (rem ? rem : 0)) * 8 + (threadIdx.x >> 6), nshort * 8); }
    }
    SEAM(1);
    if (IN(2)) { if (a.p0mask & 32) phase_fftpre(a, lds); __syncthreads(); if (a.p0mask & 64) phase_sgu(a, lds); }
    SEAM(2);
    if (IN(3)) {
        FftSched S; S.c = c; S.G = G; S.A = (const char*)(ws + WS_WM); S.B = (const char*)(ws + WS_Z);
        EpiFft E; E.FM = (bf16_t*)(ws + WS_FM);
        gemm_phase(lds, 512, 512, 512, (size_t)HALF * 512 * 2, S, E);
    }
    SEAM(3);
    if (IN(4)) {
        FlatSched S; S.nM = T / 256; S.nN = 4; S.nwg = S.nM * S.nN; S.G = G; S.c = c;
        { S.A = (const char*)(ws + WS_FM); S.B = (const char*)(ws + WS_WFO); S.tstepA = 256 * 1024 * 2; S.tstepB = 256 * 1024 * 2;
          EpiMerge<0> E; E.Y = (bf16_t*)(ws + WS_MG); E.G = (const bf16_t*)(ws + WS_G);
          gemm_phase(lds, 1024, 1024, 1024, (size_t)HALF * 1024 * 2, S, E); }
        { S.A = (const char*)(ws + WS_SG); S.B = (const char*)(ws + WS_WSO); S.tstepA = 256 * 512 * 2; S.tstepB = 256 * 512 * 2;
          EpiMerge<1> E; E.Y = (bf16_t*)(ws + WS_MG); E.G = (const bf16_t*)(ws + WS_G);
          gemm_phase(lds, 512, 512, 512, (size_t)HALF * 512 * 2, S, E); }
    }
    SEAM(4);
    if (IN(5)) {
        FlatSched S; S.nM = T / 256; S.nN = 4; S.nwg = S.nM * S.nN; S.G = G; S.c = c; S.A = (const char*)(ws + WS_MG); S.B = (const char*)(ws + WS_WO); S.tstepA = 256 * 1024 * 2; S.tstepB = 256 * 1024 * 2;
        EpiRowSS E; E.O = (bf16_t*)(ws + WS_O); E.SSQ = (float*)(ws + WS_SS1);
        gemm_phase(lds, 1024, 1024, 1024, (size_t)HALF * 1024 * 2, S, E);
    }
    SEAM(5);
    if (IN(6)) phase_mid(a);
    SEAM(6);
    if (IN(7)) {
        FlatSched S; S.nM = T / 256; S.nN = 32; S.nwg = S.nM * S.nN; S.G = G; S.c = c; S.A = (const char*)(ws + WS_H2); S.B = (const char*)(ws + WS_WUP); S.tstepA = 256 * 1024 * 2; S.tstepB = 128 * 1024 * 2;
        EpiUp E; E.ACT = (bf16_t*)(ws + WS_ACT); E.SB = (float*)(ws + WS_SB); E.cw = a.conv_w; E.cb = a.conv_b; E.X = (LAS float*)(lds + XCH_OFF);
        gemm_phase(lds, 1024, 1024, 1024, (size_t)DFF * 1024 * 2, S, E);
    }
    SEAM(7);
    if (IN(8)) {
        FlatSched S; S.nM = T / 256; S.nN = 4; S.nwg = S.nM * S.nN; S.G = G; S.c = c; S.A = (const char*)(ws + WS_ACT); S.B = (const char*)(ws + WS_WDN); S.tstepA = (size_t)256 * DFF * 2; S.tstepB = (size_t)256 * DFF * 2;
        { Unit fu; for (int i = 0; S.next(i, fu); ++i) fix_panel(a, fu.pm); }
        asm volatile("s_waitcnt vmcnt(0)" ::: "memory"); __syncthreads();
        EpiRowSS E; E.O = (bf16_t*)(ws + WS_FF); E.SSQ = (float*)(ws + WS_SS2);
        gemm_phase(lds, DFF, DFF, DFF, (size_t)HALF * DFF * 2, S, E);
    }
    SEAM(8);
    if (IN(9)) phase_final(a);
#undef IN
#undef SEAM
}

extern "C" void kernel_launch(void* const* d_in, const int* in_sizes, int n_in, void* d_out, int out_size, void* d_ws, size_t ws_size, hipStream_t stream) {
    static int grid = 0;
    if (grid == 0) {
        if (n_in != 18 || in_sizes[0] != TP * D || out_size != T * D || ws_size < WS_END) { fprintf(stderr, "kernel_launch: unexpected shapes / workspace (n_in %d, ws %zu, need %zu)\n", n_in, ws_size, (size_t)WS_END); grid = -1; return; }
        int dev = 0, cus = 0, per_cu = 0;
        hipGetDevice(&dev); hipDeviceGetAttribute(&cus, hipDeviceAttributeMultiprocessorCount, dev);
        if (hipFuncSetAttribute((const void*)fwd_kernel, hipFuncAttributeMaxDynamicSharedMemorySize, LDS_BYTES) != hipSuccess) { fprintf(stderr, "kernel_launch: hipFuncSetAttribute failed\n"); grid = -1; return; }
        if (hipOccupancyMaxActiveBlocksPerMultiprocessor(&per_cu, (const void*)fwd_kernel, 512, LDS_BYTES) != hipSuccess || per_cu < 1) { fprintf(stderr, "kernel_launch: occupancy query says %d\n", per_cu); per_cu = 1; }
        (void)hipGetLastError();
        grid = cus;
    }
    if (grid < 0) return;
    Args a{};
    a.xp = (const float*)d_in[0]; a.xs = (const float*)d_in[1]; a.g_pre_mix = (const float*)d_in[2]; a.w_in = (const float*)d_in[3]; a.ln_g = (const float*)d_in[4]; a.ln_b = (const float*)d_in[5];
    a.w_s = (const float*)d_in[6]; a.b_s = (const float*)d_in[7]; a.w_fo = (const float*)d_in[8]; a.w_so = (const float*)d_in[9]; a.w_o = (const float*)d_in[10]; a.g_post_mix = (const float*)d_in[11];
    a.g_pre_ffn = (const float*)d_in[12]; a.w_up = (const float*)d_in[13]; a.conv_w = (const float*)d_in[14]; a.conv_b = (const float*)d_in[15]; a.w_down = (const float*)d_in[16]; a.g_post_ffn = (const float*)d_in[17];
    a.out = (float*)d_out; a.ws = (unsigned char*)d_ws; a.p0mask = 0x7f;
#if MK_MULTI
    for (int p = 0; p < NPHASE; ++p) { a.ph_lo = p; a.ph_hi = p + 1; hipLaunchKernelGGL(fwd_kernel, dim3(grid), dim3(512), LDS_BYTES, stream, a); }
#else
    a.ph_lo = 0; a.ph_hi = NPHASE;
    void* args[] = {&a};
    hipError_t e = hipLaunchCooperativeKernel((const void*)fwd_kernel, dim3(grid), dim3(512), args, LDS_BYTES, stream);
    if (e != hipSuccess) fprintf(stderr, "cooperative launch failed: %s (grid %d)\n", hipGetErrorString(e), grid);
#ifdef PROBE_PHASE
    a.ph_lo = PROBE_PHASE; a.ph_hi = PROBE_PHASE + 1; a.p0mask = PROBE_P0MASK; hipLaunchKernelGGL(fwd_kernel, dim3(grid), dim3(512), LDS_BYTES, stream, a);
#endif
#endif
}
```

```cpp
#include <hip/hip_runtime.h>
#include <hip/hip_cooperative_groups.h>
#include <cstdio>
#include <cstdint>
namespace cg = cooperative_groups;

#ifndef PROBE_P0MASK
#define PROBE_P0MASK 0x7f
#endif
#ifndef MK_MULTI
#define MK_MULTI 0
#endif

#define LAS __attribute__((address_space(3)))
typedef unsigned short bf16_t;
typedef short bf16x8 __attribute__((ext_vector_type(8)));
typedef float f32x4 __attribute__((ext_vector_type(4)));
typedef unsigned u32x4 __attribute__((ext_vector_type(4)));
typedef unsigned u32x2 __attribute__((ext_vector_type(2)));

constexpr int T = 81920, TP = 65536, D = 1024, NPROJ = 3584, DFF = 4096;
constexpr int SEQ_P = 2048, SEQ_S = 8192;
constexpr float EPS = 1e-6f;
constexpr size_t MiB = 1ull << 20;
constexpr size_t WS_WIN = 0, WS_WFO = 7 * MiB, WS_WSO = 9 * MiB, WS_WO = 10 * MiB, WS_WUP = 12 * MiB, WS_WDN = 28 * MiB, WS_WS = 36 * MiB;
constexpr size_t WS_WM = 40 * MiB, WS_Z = 41 * MiB;
constexpr size_t WS_H = 176 * MiB, WS_FM = 176 * MiB;
constexpr size_t WS_FT = 336 * MiB, WS_V = 416 * MiB, WS_U = 496 * MiB, WS_G = 576 * MiB;
constexpr size_t WS_MG = 336 * MiB, WS_O = 576 * MiB, WS_H2 = 40 * MiB, WS_ACT = 200 * MiB, WS_SB = 840 * MiB, WS_FF = 40 * MiB;
constexpr size_t WS_BAR = 976 * MiB;
constexpr size_t WS_SG = 896 * MiB;
constexpr size_t WS_SS1 = 880 * MiB, WS_SS2 = 885 * MiB, WS_END = 977 * MiB;

constexpr int BM = 256, BK = 64, HALF = 128, HTB = HALF * BK * 2, STAGE_BYTES = 8 * HTB, NXCD = 8, WGM = 8;
constexpr int XCH_OFF = STAGE_BYTES, XCH_BYTES = 8192, BAR_ST_OFF = STAGE_BYTES + XCH_BYTES, LDS_BYTES = STAGE_BYTES + XCH_BYTES + 16;

struct Args {
    const float *xp, *xs, *g_pre_mix, *w_in, *ln_g, *ln_b, *w_s, *b_s, *w_fo, *w_so, *w_o, *g_post_mix, *g_pre_ffn, *w_up, *conv_w, *conv_b, *w_down, *g_post_ffn;
    float* out; unsigned char* ws; int ph_lo, ph_hi, p0mask, pad_;
};

__device__ __forceinline__ unsigned cvt_pk_bf16(float lo, float hi) { unsigned r; asm volatile("v_cvt_pk_bf16_f32 %0, %1, %2" : "=v"(r) : "v"(lo), "v"(hi)); return r; }
__device__ __forceinline__ bf16_t f2bf(float x) { return (bf16_t)(cvt_pk_bf16(x, x) & 0xffffu); }
__device__ __forceinline__ float bflo(unsigned u) { return __uint_as_float(u << 16); }
__device__ __forceinline__ float bfhi(unsigned u) { return __uint_as_float(u & 0xffff0000u); }
template <int CTRL> __device__ __forceinline__ float dppx(float x) { return __builtin_bit_cast(float, __builtin_amdgcn_mov_dpp(__builtin_bit_cast(int, x), CTRL, 0xf, 0xf, true)); }
__device__ __forceinline__ float row16_sum(float v) { v += dppx<0xB1>(v); v += dppx<0x4E>(v); v += dppx<0x141>(v); v += dppx<0x128>(v); return v; }
__device__ __forceinline__ float wave_sum(float v) { v = row16_sum(v); v += __shfl_xor(v, 16); v += __shfl_xor(v, 32); return v; }
__device__ __forceinline__ float sigmoid_f(float x) { return __builtin_amdgcn_rcpf(1.0f + __builtin_amdgcn_exp2f(-1.4426950409f * x)); }
__device__ __forceinline__ float gelu_f(float x) {
    const float q = x * __builtin_fmaf(x * x, -0.10294324f, -2.3022082f);
    return x * __builtin_amdgcn_rcpf(1.0f + __builtin_amdgcn_exp2f(q));
}
#define LDS_WAIT() asm volatile("s_waitcnt lgkmcnt(0)" ::: "memory")

__device__ __forceinline__ int lds_byte(int r, int c) { const int st = (r >> 4) * 2 + (c >> 5), rr = r & 15, cc = c & 31, ob = rr * 64 + cc * 2; return st * 1024 + (ob ^ (((ob >> 9) & 1) << 5)); }
__device__ __forceinline__ void stage_rc(int b, int& R, int& C) { const int st = b / 1024, sb = b % 1024, swz = sb ^ (((sb >> 9) & 1) << 5); R = (st >> 1) * 16 + swz / 64; C = (st & 1) * 32 + (swz % 64) / 2; }
__device__ __forceinline__ int perm32(int rho) { const int n = rho >> 4, i = rho & 15; return 8 * (i >> 2) + 4 * n + (i & 3); }

struct Unit { int pm, pn, z; };

struct FlatSched {
    int nM, nN, nwg, G, c; const char *A, *B; size_t tstepA, tstepB;
    __device__ __forceinline__ bool next(int i, Unit& u) const {
        const long L = (long)i * G + c; if (L >= nwg) return false;
        int wgid = (int)L; { const int q = nwg / NXCD, r = nwg % NXCD, xcd = wgid % NXCD, off = wgid / NXCD; wgid = (xcd < r ? xcd * (q + 1) : r * (q + 1) + (xcd - r) * q) + off; }
        const int nig = WGM * nN, gid = wgid / nig, fm = gid * WGM, gsz = (nM - fm) < WGM ? (nM - fm) : WGM;
        u.pm = fm + ((wgid % nig) % gsz); u.pn = (wgid % nig) / gsz; u.z = 0; return true;
    }
    __device__ __forceinline__ const char* aptr(const Unit& u) const { return A + (size_t)u.pm * tstepA; }
    __device__ __forceinline__ const char* bptr(const Unit& u) const { return B + (size_t)u.pn * tstepB; }
};
struct FftSched {
    int c, G; const char *A, *B;
    __device__ __forceinline__ bool next(int i, Unit& u) const {
        const int L = i * G + c; if (L >= 776) return false;
        if (L < 640) { u.z = L / 20; const int r = L % 20; u.pm = r & 1; u.pn = r >> 1; }
        else { const int L2 = L - 640; u.z = 32 + L2 / 68; const int r = L2 % 68; u.pm = r & 1; u.pn = r >> 1; }
        return true;
    }
    __device__ __forceinline__ const char* aptr(const Unit& u) const { return A + (size_t)u.pm * 256 * 512 * 2; }
    __device__ __forceinline__ const char* bptr(const Unit& u) const { const size_t zrow0 = u.z < 32 ? (size_t)u.z * 2560 : (size_t)32 * 2560 + (size_t)(u.z - 32) * 8704; return B + (zrow0 + (size_t)u.pn * 256) * 512 * 2; }
};

template <class E> struct RowPerm { static constexpr bool v = false; };
struct EpiUp; template <> struct RowPerm<EpiUp> { static constexpr bool v = true; };
template <class Epi, class Sched>
__device__ __forceinline__ void gemm_phase(LAS unsigned char* lds, const int K, const int lda, const int ldb, const size_t hstepB, const Sched& S, const Epi& E) {
    const int tid = threadIdx.x, wid = __builtin_amdgcn_readfirstlane(tid >> 6), lane = tid & 63, wr = wid >> 2, wc = wid & 3, fr = lane & 15, fq = lane >> 4;
    const int nt = K / BK;
    unsigned voffA[2], voffB[2];
#pragma unroll
    for (int i = 0; i < 2; ++i) { int R, C; stage_rc(tid * 16 + i * 8192, R, C); const int Rb = (R & ~31) + perm32(R & 31);
        const int Ra = RowPerm<Epi>::v ? ((R & ~63) + 4 * (R & 15) + ((R >> 4) & 3)) : R;
        voffA[i] = (unsigned)(Ra * lda + C) * 2u; voffB[i] = (unsigned)(Rb * ldb + C) * 2u; }
    const size_t kstep = (size_t)(BK * 2);
    const size_t hstepA = (size_t)HALF * lda * 2;
    const unsigned ldsw = (unsigned)wid * 1024u;
    const int aoff = lds_byte(wr * 64 + fr, fq * 8), boff = lds_byte(wc * 32 + fr, fq * 8);
#define PG8_SA(b, h) (((b) * 2 + (h)) * HTB)
#define PG8_SB(b, h) ((4 + (b) * 2 + (h)) * HTB)
#define PG8_STAGE(bufoff, gbase, voff) do { _Pragma("unroll") for (int _i = 0; _i < 2; ++_i) \
        __builtin_amdgcn_global_load_lds((const unsigned*)((const char*)(gbase) + (voff)[_i]), (LAS unsigned*)(lds + (bufoff) + ldsw + _i * 8192), 16, 0, 0); } while (0)
#define PG8_LDA(dst, b, h) do { _Pragma("unroll") for (int m = 0; m < 4; ++m) _Pragma("unroll") for (int k = 0; k < 2; ++k) dst[m][k] = *(const LAS bf16x8*)(lds + PG8_SA(b, h) + aoff + m * 2048 + k * 1024); } while (0)
#define PG8_LDB(dst, b, h) do { _Pragma("unroll") for (int n = 0; n < 2; ++n) _Pragma("unroll") for (int k = 0; k < 2; ++k) dst[n][k] = *(const LAS bf16x8*)(lds + PG8_SB(b, h) + boff + n * 2048 + k * 1024); } while (0)
#define PG8_MMA(ai, bj, At, Bt) do { __builtin_amdgcn_s_setprio(1); _Pragma("unroll") for (int m = 0; m < 4; ++m) _Pragma("unroll") for (int n = 0; n < 2; ++n) _Pragma("unroll") for (int k = 0; k < 2; ++k) \
        acc[ai][bj][m][n] = __builtin_amdgcn_mfma_f32_16x16x32_bf16(Bt[n][k], At[m][k], acc[ai][bj][m][n], 0, 0, 0); __builtin_amdgcn_s_setprio(0); } while (0)
#define PG8_WAIT_V(n) asm volatile("s_waitcnt vmcnt(" #n ")" ::: "memory")
#define PG8_WAIT_L(n) asm volatile("s_waitcnt lgkmcnt(" #n ")" ::: "memory")
#define PG8_BAR __builtin_amdgcn_s_barrier()
#define PG8_SCHED __builtin_amdgcn_sched_barrier(0)
    Unit cur, nxt; int ui = 0;
    if (!S.next(0, cur)) return;
    f32x4 acc[2][2][4][2];
#pragma unroll
    for (int a = 0; a < 2; ++a)
#pragma unroll
        for (int b = 0; b < 2; ++b)
#pragma unroll
            for (int m = 0; m < 4; ++m)
#pragma unroll
                for (int n = 0; n < 2; ++n) acc[a][b][m][n] = (f32x4){0.f, 0.f, 0.f, 0.f};
    bf16x8 At[4][2], B0[2][2], B1[2][2];
    const char* cA = S.aptr(cur); const char* cB = S.bptr(cur);
    PG8_STAGE(PG8_SB(0, 0), cB, voffB); PG8_STAGE(PG8_SB(0, 1), cB + hstepB, voffB); PG8_STAGE(PG8_SA(0, 0), cA, voffA); PG8_STAGE(PG8_SA(0, 1), cA + hstepA, voffA);
    if (wr == 1) PG8_BAR;
    PG8_WAIT_V(2); PG8_BAR;
    PG8_STAGE(PG8_SB(1, 0), cB + kstep, voffB); PG8_STAGE(PG8_SA(1, 0), cA + kstep, voffA); PG8_STAGE(PG8_SB(1, 1), cB + hstepB + kstep, voffB);
    PG8_WAIT_V(6); PG8_BAR;
    for (;;) {
        const bool has_next = S.next(ui + 1, nxt);
        const char* nA = has_next ? S.aptr(nxt) : cA; const char* nB = has_next ? S.bptr(nxt) : cB;
        for (int t = 0; t < nt; t += 2) {
            const bool last = (t == nt - 2);
            const char* a1 = cA + (size_t)(t + 1) * kstep;
            const char* a2 = last ? nA : cA + (size_t)(t + 2) * kstep; const char* b2 = last ? nB : cB + (size_t)(t + 2) * kstep;
            const char* a3 = a2 + kstep; const char* b3 = b2 + kstep;
            PG8_LDB(B0, 0, 0); PG8_LDB(B1, 0, 1); PG8_SCHED; PG8_LDA(At, 0, 0); PG8_STAGE(PG8_SA(1, 1), a1 + hstepA, voffA);
            PG8_WAIT_V(8); PG8_WAIT_L(0); PG8_BAR; PG8_MMA(0, 0, At, B0); PG8_MMA(0, 1, At, B1); PG8_BAR; PG8_SCHED;
            PG8_LDA(At, 0, 1); PG8_STAGE(PG8_SB(0, 0), b2, voffB); PG8_STAGE(PG8_SB(0, 1), b2 + hstepB, voffB); PG8_STAGE(PG8_SA(0, 0), a2, voffA);
            PG8_WAIT_V(8); PG8_WAIT_L(0); PG8_BAR; PG8_MMA(1, 0, At, B0); PG8_MMA(1, 1, At, B1); PG8_BAR; PG8_SCHED;
            PG8_LDB(B0, 1, 0); PG8_LDB(B1, 1, 1); PG8_SCHED; PG8_LDA(At, 1, 0); PG8_STAGE(PG8_SA(0, 1), a2 + hstepA, voffA);
            PG8_WAIT_V(8); PG8_WAIT_L(0); PG8_BAR; PG8_MMA(0, 0, At, B0); PG8_MMA(0, 1, At, B1); PG8_BAR; PG8_SCHED;
            PG8_LDA(At, 1, 1); PG8_STAGE(PG8_SB(1, 0), b3, voffB); PG8_STAGE(PG8_SB(1, 1), b3 + hstepB, voffB); PG8_STAGE(PG8_SA(1, 0), a3, voffA);
            PG8_WAIT_V(8); PG8_WAIT_L(0); PG8_BAR; PG8_MMA(1, 0, At, B0); PG8_MMA(1, 1, At, B1); PG8_BAR; PG8_SCHED;
        }
        if (wr == 0) PG8_BAR;
        E(acc, cur, wr, wc, fr, fq);
        if (!has_next) break;
#pragma unroll
        for (int a = 0; a < 2; ++a)
#pragma unroll
            for (int b = 0; b < 2; ++b)
#pragma unroll
                for (int m = 0; m < 4; ++m)
#pragma unroll
                    for (int n = 0; n < 2; ++n) acc[a][b][m][n] = (f32x4){0.f, 0.f, 0.f, 0.f};
        cur = nxt; cA = nA; cB = nB; ++ui;
        if (wr == 1) PG8_BAR;
    }
    PG8_WAIT_V(0);
    PG8_BAR;
#undef PG8_SA
#undef PG8_SB
#undef PG8_STAGE
#undef PG8_LDA
#undef PG8_LDB
#undef PG8_MMA
#undef PG8_WAIT_V
#undef PG8_WAIT_L
#undef PG8_BAR
#undef PG8_SCHED
}

typedef f32x4 AccT[2][2][4][2];

struct EpiInProj {
    bf16_t* Ft; unsigned char* wsb;
    __device__ __forceinline__ void operator()(const AccT& acc, const Unit& u, int wr, int wc, int fr, int fq) const {
        const int tb = u.pm * BM;
        if (u.pn < 2) {
            int S, ts0; if (tb < TP) { S = SEQ_P; ts0 = tb & ~(SEQ_P - 1); } else { S = SEQ_S; ts0 = TP + ((tb - TP) & ~(SEQ_S - 1)); }
            bf16_t* ft = Ft + (size_t)ts0 * 512 + (tb - ts0 + wr * 64 + fr);
#pragma unroll
            for (int bj = 0; bj < 2; ++bj)
#pragma unroll
                for (int n = 0; n < 2; ++n) { const int c0 = 256 * u.pn + 128 * bj + 32 * wc + 8 * fq + 4 * n;
#pragma unroll
                    for (int j = 0; j < 4; ++j) { bf16_t* cp = ft + (size_t)(c0 + j) * S;
#pragma unroll
                        for (int ai = 0; ai < 2; ++ai)
#pragma unroll
                            for (int m = 0; m < 4; ++m) cp[ai * HALF + m * 16] = f2bf(acc[ai][bj][m][n][j]); } }
        } else {
            const bool sig = u.pn >= 6; const size_t isU = u.pn < 4 ? 1 : 0, isV = (u.pn >= 4 && u.pn < 6) ? 1 : 0;
            bf16_t* base = (bf16_t*)(wsb + WS_G + isU * (WS_U - WS_G) + isV * (WS_V - WS_G));
            const int ldc = sig ? 2048 : 512, colt = sig ? (u.pn - 6) * 256 : ((u.pn - 2) & 1) * 256;
            const int row0 = tb + wr * 64 + fr, col0 = colt + wc * 32 + 8 * fq;
#pragma unroll
            for (int ai = 0; ai < 2; ++ai)
#pragma unroll
                for (int m = 0; m < 4; ++m) { bf16_t* rowp = base + (size_t)(row0 + ai * HALF + m * 16) * ldc + col0;
#pragma unroll
                    for (int bj = 0; bj < 2; ++bj) { f32x4 v0 = acc[ai][bj][m][0], v1 = acc[ai][bj][m][1];
                        if (sig) {
#pragma unroll
                            for (int j = 0; j < 4; ++j) { v0[j] = sigmoid_f(v0[j]); v1[j] = sigmoid_f(v1[j]); }
                        } else {
#pragma unroll
                            for (int j = 0; j < 4; ++j) { v0[j] = gelu_f(v0[j]); v1[j] = gelu_f(v1[j]); }
                        }
                        u32x4 w; w.x = cvt_pk_bf16(v0[0], v0[1]); w.y = cvt_pk_bf16(v0[2], v0[3]); w.z = cvt_pk_bf16(v1[0], v1[1]); w.w = cvt_pk_bf16(v1[2], v1[3]);
                        *(u32x4*)(rowp + bj * HALF) = w; } }
        }
    }
};

struct EpiFft {
    bf16_t* FM;
    __device__ __forceinline__ void operator()(const AccT& acc, const Unit& u, int wr, int wc, int fr, int fq) const {
        int S, N1, tok0; if (u.z < 32) { S = SEQ_P; N1 = 8; tok0 = u.z * SEQ_P; } else { S = SEQ_S; N1 = 32; tok0 = TP + (u.z - 32) * SEQ_S; }
        const int k1 = u.pn >> 1, ch = u.pn & 1, part = u.pm; const bool mirror = k1 > 0 && k1 < (N1 >> 1);
        const int c0 = part * 512 + ch * 256 + 32 * wc + 8 * fq;
#pragma unroll
        for (int ai = 0; ai < 2; ++ai)
#pragma unroll
            for (int m = 0; m < 4; ++m) { const int k2 = ai * HALF + wr * 64 + m * 16 + fr, k = k1 + N1 * k2;
#pragma unroll
                for (int bj = 0; bj < 2; ++bj) { const f32x4 v0 = acc[ai][bj][m][0], v1 = acc[ai][bj][m][1];
                    u32x4 w; w.x = cvt_pk_bf16(v0[0], v0[1]); w.y = cvt_pk_bf16(v0[2], v0[3]); w.z = cvt_pk_bf16(v1[0], v1[1]); w.w = cvt_pk_bf16(v1[2], v1[3]);
                    *(u32x4*)(FM + (size_t)(tok0 + k) * 1024 + c0 + bj * HALF) = w;
                    if (mirror) { if (part) { w.x ^= 0x80008000u; w.y ^= 0x80008000u; w.z ^= 0x80008000u; w.w ^= 0x80008000u; }
                        *(u32x4*)(FM + (size_t)(tok0 + S - k) * 1024 + c0 + bj * HALF) = w; }
                } }
    }
};

template <int MODE> struct EpiMerge {
    bf16_t* Y; const bf16_t* G;
    __device__ __forceinline__ void operator()(const AccT& acc, const Unit& u, int wr, int wc, int fr, int fq) const {
        const int row0 = u.pm * BM + wr * 64 + fr, col0 = u.pn * BM + wc * 32 + 8 * fq;
#pragma unroll
        for (int ai = 0; ai < 2; ++ai)
#pragma unroll
            for (int m = 0; m < 4; ++m) { const size_t row = (size_t)(row0 + ai * HALF + m * 16);
#pragma unroll
                for (int bj = 0; bj < 2; ++bj) { const f32x4 v0 = acc[ai][bj][m][0], v1 = acc[ai][bj][m][1];
                    const u32x4 g = *(const u32x4*)(G + row * 2048 + MODE * 1024 + col0 + bj * HALF);
                    float r[8] = {bflo(g.x) * v0[0], bfhi(g.x) * v0[1], bflo(g.y) * v0[2], bfhi(g.y) * v0[3], bflo(g.z) * v1[0], bfhi(g.z) * v1[1], bflo(g.w) * v1[2], bfhi(g.w) * v1[3]};
                    bf16_t* yp = Y + row * 1024 + col0 + bj * HALF;
                    if (MODE == 1) { const u32x4 y = *(const u32x4*)yp;
                        r[0] += bflo(y.x); r[1] += bfhi(y.x); r[2] += bflo(y.y); r[3] += bfhi(y.y); r[4] += bflo(y.z); r[5] += bfhi(y.z); r[6] += bflo(y.w); r[7] += bfhi(y.w); }
                    u32x4 w; w.x = cvt_pk_bf16(r[0], r[1]); w.y = cvt_pk_bf16(r[2], r[3]); w.z = cvt_pk_bf16(r[4], r[5]); w.w = cvt_pk_bf16(r[6], r[7]);
                    *(u32x4*)yp = w; } }
    }
};

struct EpiRowSS {
    bf16_t* O; float* SSQ;
    __device__ __forceinline__ void operator()(const AccT& acc, const Unit& u, int wr, int wc, int fr, int fq) const {
        const int row0 = u.pm * BM + wr * 64 + fr, col0 = u.pn * BM + wc * 32 + 8 * fq;
#pragma unroll
        for (int ai = 0; ai < 2; ++ai)
#pragma unroll
            for (int m = 0; m < 4; ++m) { const size_t row = (size_t)(row0 + ai * HALF + m * 16); float s = 0.f;
#pragma unroll
                for (int bj = 0; bj < 2; ++bj) { const f32x4 v0 = acc[ai][bj][m][0], v1 = acc[ai][bj][m][1];
                    s += (v0[0] * v0[0] + v0[1] * v0[1]) + (v0[2] * v0[2] + v0[3] * v0[3]) + (v1[0] * v1[0] + v1[1] * v1[1]) + (v1[2] * v1[2] + v1[3] * v1[3]);
                    u32x4 w; w.x = cvt_pk_bf16(v0[0], v0[1]); w.y = cvt_pk_bf16(v0[2], v0[3]); w.z = cvt_pk_bf16(v1[0], v1[1]); w.w = cvt_pk_bf16(v1[2], v1[3]);
                    *(u32x4*)(O + row * 1024 + col0 + bj * HALF) = w; }
                s += __shfl_xor(s, 16); s += __shfl_xor(s, 32);
                if (fq == 0) SSQ[row * 16 + u.pn * 4 + wc] = s; }
    }
};

typedef _Float16 h2_t __attribute__((ext_vector_type(2)));
__device__ __forceinline__ h2_t pk_h2(float a, float b) { return __builtin_bit_cast(h2_t, __builtin_amdgcn_cvt_pkrtz(a, b)); }
template <int CTRL> __device__ __forceinline__ h2_t dpp_h2(h2_t x) { return __builtin_bit_cast(h2_t, __builtin_amdgcn_mov_dpp(__builtin_bit_cast(int, x), CTRL, 0xf, 0xf, true)); }
__device__ __forceinline__ h2_t sel_h2(bool c, h2_t a, h2_t b) { return __builtin_bit_cast(h2_t, c ? __builtin_bit_cast(int, a) : __builtin_bit_cast(int, b)); }
template <int CTRL> __device__ __forceinline__ float dpp_f(float x) { return __builtin_bit_cast(float, __builtin_amdgcn_update_dpp(0, __builtin_bit_cast(int, x), CTRL, 0xf, 0xf, false)); }
struct EpiUp {
    bf16_t* ACT; float* SB; const float *cw, *cb; LAS float* X;
    __device__ __forceinline__ void operator()(const AccT& acc, const Unit& u, int wr, int wc, int fr, int fq) const {
        const int ccb = 32 * wc + 8 * fq;
#pragma unroll
        for (int ai = 0; ai < 2; ++ai) { const int q4 = ai * 2 + wr;
#pragma unroll
            for (int bj = 0; bj < 2; ++bj)
#pragma unroll
                for (int n = 0; n < 2; ++n) {
                    if (fr == 0) *(LAS f32x4*)(X + ((q4 * 2 + 0) * 2 + bj) * 128 + ccb + 4 * n) = acc[ai][bj][0][n];
                    if (fr == 15) *(LAS f32x4*)(X + ((q4 * 2 + 1) * 2 + bj) * 128 + ccb + 4 * n) = acc[ai][bj][3][n];
                    const int scol = bj * 4096 + 128 * u.pn + ccb + 4 * n;
                    if (q4 == 0 && fr == 0) { *(f32x4*)(SB + ((size_t)u.pm * 4 + 0) * 8192 + scol) = acc[ai][bj][0][n]; *(f32x4*)(SB + ((size_t)u.pm * 4 + 1) * 8192 + scol) = acc[ai][bj][1][n]; }
                    if (q4 == 3 && fr == 15) { *(f32x4*)(SB + ((size_t)u.pm * 4 + 2) * 8192 + scol) = acc[ai][bj][2][n]; *(f32x4*)(SB + ((size_t)u.pm * 4 + 3) * 8192 + scol) = acc[ai][bj][3][n]; }
                } }
        LDS_WAIT(); __builtin_amdgcn_s_barrier(); asm volatile("" ::: "memory");
        unsigned keep[2][4][2];
#pragma unroll
        for (int n = 0; n < 2; ++n) {
            const int colg = 128 * u.pn + ccb + 4 * n;
            h2_t w0[2][2], w1[2][2], w2[2][2], bb[2][2];
#pragma unroll
            for (int bj = 0; bj < 2; ++bj) { const int col = bj * 4096 + colg;
                const f32x4 a0 = *(const f32x4*)(cw + col), a1 = *(const f32x4*)(cw + 8192 + col), a2 = *(const f32x4*)(cw + 16384 + col), ab = *(const f32x4*)(cb + col);
                w0[bj][0] = pk_h2(a0[0], a0[1]); w0[bj][1] = pk_h2(a0[2], a0[3]); w1[bj][0] = pk_h2(a1[0], a1[1]); w1[bj][1] = pk_h2(a1[2], a1[3]);
                w2[bj][0] = pk_h2(a2[0], a2[1]); w2[bj][1] = pk_h2(a2[2], a2[3]); bb[bj][0] = pk_h2(ab[0], ab[1]); bb[bj][1] = pk_h2(ab[2], ab[3]); }
            const h2_t C1 = (h2_t){(_Float16)-2.3022082f, (_Float16)-2.3022082f}, C2 = (h2_t){(_Float16)-0.10294324f, (_Float16)-0.10294324f}, ONE = (h2_t){(_Float16)1.0f, (_Float16)1.0f};
#pragma unroll
            for (int ai = 0; ai < 2; ++ai) { const int q4 = ai * 2 + wr;
                h2_t xp[2][2], xn[2][2], ch[2][4][2];
#pragma unroll
                for (int bj = 0; bj < 2; ++bj) {
                    f32x4 fp = (f32x4){0.f, 0.f, 0.f, 0.f}, fn = (f32x4){0.f, 0.f, 0.f, 0.f};
                    if (fr == 15 && q4 > 0) fp = *(const LAS f32x4*)(X + (((q4 - 1) * 2 + 1) * 2 + bj) * 128 + ccb + 4 * n);
                    if (fr == 0 && q4 < 3) fn = *(const LAS f32x4*)(X + (((q4 + 1) * 2 + 0) * 2 + bj) * 128 + ccb + 4 * n);
                    xp[bj][0] = pk_h2(fp[0], fp[1]); xp[bj][1] = pk_h2(fp[2], fp[3]); xn[bj][0] = pk_h2(fn[0], fn[1]); xn[bj][1] = pk_h2(fn[2], fn[3]);
#pragma unroll
                    for (int m = 0; m < 4; ++m) { const f32x4 v = acc[ai][bj][m][n]; ch[bj][m][0] = pk_h2(v[0], v[1]); ch[bj][m][1] = pk_h2(v[2], v[3]); }
                }
#pragma unroll
                for (int m = 0; m < 4; ++m) {
                    unsigned wq[2];
#pragma unroll
                    for (int pr = 0; pr < 2; ++pr) {
                        h2_t up[2];
#pragma unroll
                        for (int bj = 0; bj < 2; ++bj) {
                            const h2_t cur = ch[bj][m][pr];
                            h2_t pv, nv;
                            if (m == 0) pv = dpp_h2<0x121>(sel_h2(fr == 15, xp[bj][pr], ch[bj][3][pr]));
                            else pv = ch[bj][m == 0 ? 0 : m - 1][pr];
                            if (m == 3) nv = dpp_h2<0x12F>(sel_h2(fr == 0, xn[bj][pr], ch[bj][0][pr]));
                            else nv = ch[bj][m == 3 ? 3 : m + 1][pr];
                            h2_t r = __builtin_elementwise_fma(w1[bj][pr], cur, bb[bj][pr]);
                            r = __builtin_elementwise_fma(w0[bj][pr], pv, r);
                            r = __builtin_elementwise_fma(w2[bj][pr], nv, r);
                            up[bj] = r;
                        }
                        const h2_t g = up[0], q = g * __builtin_elementwise_fma(g * g, C2, C1);
                        const h2_t d = __builtin_elementwise_exp2(q) + ONE;
                        h2_t rc; rc.x = __builtin_amdgcn_rcph(d.x); rc.y = __builtin_amdgcn_rcph(d.y);
                        const h2_t o = (g * rc) * up[1];
                        wq[pr] = cvt_pk_bf16((float)o.x, (float)o.y);
                    }
                    if (n == 0) { keep[ai][m][0] = wq[0]; keep[ai][m][1] = wq[1]; }
                    else { u32x4 w; w.x = keep[ai][m][0]; w.y = keep[ai][m][1]; w.z = wq[0]; w.w = wq[1];
                        const size_t row = (size_t)(u.pm * BM + ai * HALF + wr * 64 + 4 * fr + m);
                        *(u32x4*)(ACT + row * DFF + 128 * u.pn + ccb) = w; }
                } }
        }
    }
};

__device__ __forceinline__ void p0_transpose_item(const float* W, int K, int N, bf16_t* WT, LAS float* scr, int item, int lane) {
    const int nblk = N / 32, kb = item / nblk, nb = item % nblk, k0 = 64 * kb, n0 = 32 * nb;
#pragma unroll
    for (int i = 0; i < 32; ++i) { const int kk = 2 * i + (lane >> 5); scr[kk * 33 + (lane & 31)] = W[(size_t)(k0 + kk) * N + n0 + (lane & 31)]; }
    LDS_WAIT(); asm volatile("" ::: "memory");
    const int c = lane & 7;
#pragma unroll
    for (int j = 0; j < 4; ++j) { const int n = (lane >> 3) + 8 * j; const LAS float* s = scr + (8 * c) * 33 + n;
        u32x4 o; o.x = cvt_pk_bf16(s[0 * 33], s[1 * 33]); o.y = cvt_pk_bf16(s[2 * 33], s[3 * 33]); o.z = cvt_pk_bf16(s[4 * 33], s[5 * 33]); o.w = cvt_pk_bf16(s[6 * 33], s[7 * 33]);
        *(u32x4*)(WT + (size_t)(n0 + n) * K + k0 + 8 * c) = o; }
    LDS_WAIT(); asm volatile("" ::: "memory");
}

__device__ __forceinline__ void phase_prep(const Args& a, LAS unsigned char* lds) {
    const int tid = threadIdx.x, lane = tid & 63, wave = tid >> 6, G = gridDim.x;
    const bool prepw = wave < 2;
    const int gw = blockIdx.x * 2 + wave, NGW = G * 2;
    const size_t gt = (size_t)blockIdx.x * 128 + tid, NGT = (size_t)G * 128;
    const int hw = blockIdx.x * 6 + (wave - 2), NHW = G * 6;
    unsigned char* ws = a.ws;
    LAS float* scr = (LAS float*)(lds + wave * 8448);
    LAS float* tb128 = (LAS float*)(lds + 67584);
    if (tid < 128) tb128[tid] = cospif((float)tid * (1.0f / 64.0f));
    __syncthreads();
    if (prepw && (a.p0mask & 1)) {
        constexpr int I_IN = (D / 64) * (NPROJ / 32), I_SO = (512 / 64) * (D / 32), I_O = (D / 64) * (D / 32), I_UP = (D / 64) * (2 * DFF / 32), I_DN = (DFF / 64) * (D / 32);
        constexpr int NIT = I_IN + I_SO + I_O;
        (void)I_UP; (void)I_DN;
        for (int it = gw; it < NIT; it += NGW) {
            int r = it;
            if (r < I_IN) { p0_transpose_item(a.w_in, D, NPROJ, (bf16_t*)(ws + WS_WIN), scr, r, lane); continue; } r -= I_IN;
            if (r < I_SO) { p0_transpose_item(a.w_so, 512, D, (bf16_t*)(ws + WS_WSO), scr, r, lane); continue; } r -= I_SO;
            p0_transpose_item(a.w_o, D, D, (bf16_t*)(ws + WS_WO), scr, r, lane);
        }
    }
    if (prepw && (a.p0mask & 2)) {
        bf16_t* wfo = (bf16_t*)(ws + WS_WFO);
        for (int un = blockIdx.x + G * wave; un < 512; un += G * 2) {
            const int db = un & 3, cb = (un >> 2) & 15, cs = (un >> 6) & 1, g = un >> 7, d0 = db * 256 + lane * 4, c0 = cb * 8;
            const float* wp = a.w_fo + (size_t)(g * 128) * 1024 + d0;
            f32x4 acc[8];
#pragma unroll
            for (int e = 0; e < 8; ++e) acc[e] = (f32x4){0.f, 0.f, 0.f, 0.f};
#pragma unroll 8
            for (int l = 0; l < 128; ++l) { const f32x4 w = *(const f32x4*)(wp + (size_t)l * 1024);
#pragma unroll
                for (int e = 0; e < 8; ++e) { const int ph = (l * (c0 + e)) & 127; const float cf = cs ? -tb128[(ph - 32) & 127] : tb128[ph]; acc[e] += cf * w; } }
            const float sc = 0.08838834764831845f;
#pragma unroll
            for (int j = 0; j < 4; ++j) { u32x4 o; o.x = cvt_pk_bf16(acc[0][j] * sc, acc[1][j] * sc); o.y = cvt_pk_bf16(acc[2][j] * sc, acc[3][j] * sc); o.z = cvt_pk_bf16(acc[4][j] * sc, acc[5][j] * sc); o.w = cvt_pk_bf16(acc[6][j] * sc, acc[7][j] * sc);
                *(u32x4*)(wfo + (size_t)(d0 + j) * 1024 + cs * 512 + g * 128 + c0) = o; }
        }
    }
    if (prepw && (a.p0mask & 4)) {
        bf16_t* wm = (bf16_t*)(ws + WS_WM);
        for (size_t idx = gt; idx < (size_t)512 * 512; idx += NGT) {
            const int m = (int)(idx >> 9), kk = (int)(idx & 511), mm = m & 255, s2 = kk & 255;
            const float rev = (float)((mm * s2) & 255) * (1.0f / 256.0f), cv = __builtin_amdgcn_cosf(rev), sv = __builtin_amdgcn_sinf(rev);
            const float v = (m < 256) ? (kk < 256 ? cv : sv) : (kk < 256 ? sv : -cv);
            wm[idx] = f2bf(v);
        }
    }
    if (prepw && (a.p0mask & 8)) {
        bf16_t* wsb = (bf16_t*)(ws + WS_WS);
        for (size_t idx = gt; idx < 65536; idx += NGT) wsb[idx] = f2bf(a.w_s[idx]);
    }
    if (a.p0mask & 16) {
        bf16_t* H = (bf16_t*)(ws + WS_H);
        f32x4 gv[4];
#pragma unroll
        for (int j = 0; j < 4; ++j) gv[j] = *(const f32x4*)(a.g_pre_mix + 4 * lane + 256 * j);
        constexpr int R_H = 69632;
        for (int row0 = prepw ? R_H + gw * 4 : hw * 4; row0 < (prepw ? T : R_H); row0 += (prepw ? NGW : NHW) * 4) {
            f32x4 v[4][4]; float s[4];
#pragma unroll
            for (int rr = 0; rr < 4; ++rr) { const int row = row0 + rr; const float* xr = row < TP ? a.xp + (size_t)row * D : a.xs + (size_t)(row - TP) * D;
#pragma unroll
                for (int j = 0; j < 4; ++j) v[rr][j] = *(const f32x4*)(xr + 4 * lane + 256 * j); }
#pragma unroll
            for (int rr = 0; rr < 4; ++rr) { float t = 0.f;
#pragma unroll
                for (int j = 0; j < 4; ++j) t += (v[rr][j][0] * v[rr][j][0] + v[rr][j][1] * v[rr][j][1]) + (v[rr][j][2] * v[rr][j][2] + v[rr][j][3] * v[rr][j][3]);
                s[rr] = t; }
#pragma unroll
            for (int rr = 0; rr < 4; ++rr) s[rr] = wave_sum(s[rr]);
#pragma unroll
            for (int rr = 0; rr < 4; ++rr) { const float r = rsqrtf(s[rr] * (1.0f / D) + EPS);
#pragma unroll
                for (int j = 0; j < 4; ++j) { u32x2 o; o.x = cvt_pk_bf16(v[rr][j][0] * r * gv[j][0], v[rr][j][1] * r * gv[j][1]); o.y = cvt_pk_bf16(v[rr][j][2] * r * gv[j][2], v[rr][j][3] * r * gv[j][3]);
                    *(u32x2*)(H + (size_t)(row0 + rr) * D + 4 * lane + 256 * j) = o; } }
        }
    }
}

template <int N1, int VPL> __device__ __forceinline__ void fftpre_load(const bf16_t* ft, int S, int c, int s2, float (&x)[N1][VPL]) {
#pragma unroll
    for (int s1 = 0; s1 < N1; ++s1) {
        const bf16_t* p = ft + (size_t)c * S + 256 * s1 + s2;
        if (VPL == 4) { const u32x2 r = *(const u32x2*)p; x[s1][0] = bflo(r.x); x[s1][1] = bfhi(r.x); x[s1][2 % VPL] = bflo(r.y); x[s1][3 % VPL] = bfhi(r.y); }
        else { const unsigned r = *(const unsigned*)p; x[s1][0] = bflo(r); x[s1][1] = bfhi(r); }
    }
}
template <int N1, int VPL> __device__ __forceinline__ void fftpre_compute(const float (&x)[N1][VPL], bf16_t* zb, int S, int c, int s2, const LAS float* tb, float scale) {
#pragma unroll 1
    for (int k1 = 0; k1 <= N1 / 2; ++k1) {
        float yr[VPL], yi[VPL];
#pragma unroll
        for (int v = 0; v < VPL; ++v) { yr[v] = 0.f; yi[v] = 0.f; }
#pragma unroll
        for (int s1 = 0; s1 < N1; ++s1) { const int id = ((k1 * s1) & (N1 - 1)) * (32 / N1); const float cr = tb[id], sr = tb[(id - 8) & 31];
#pragma unroll
            for (int v = 0; v < VPL; ++v) { yr[v] += x[s1][v] * cr; yi[v] -= x[s1][v] * sr; } }
        float tr[VPL], ti[VPL];
#pragma unroll
        for (int v = 0; v < VPL; ++v) { const float rev = (float)(k1 * (s2 + v)) / (float)S, wr = __builtin_amdgcn_cosf(rev), wi = -__builtin_amdgcn_sinf(rev);
            tr[v] = (yr[v] * wr - yi[v] * wi) * scale; ti[v] = (yr[v] * wi + yi[v] * wr) * scale; }
        bf16_t* zr = zb + ((size_t)k1 * 512 + c) * 512 + s2;
        if (VPL == 4) { u32x2 o; o.x = cvt_pk_bf16(tr[0], tr[1]); o.y = cvt_pk_bf16(tr[2 % VPL], tr[3 % VPL]); *(u32x2*)zr = o; o.x = cvt_pk_bf16(ti[0], ti[1]); o.y = cvt_pk_bf16(ti[2 % VPL], ti[3 % VPL]); *(u32x2*)(zr + 256) = o; }
        else { *(unsigned*)zr = cvt_pk_bf16(tr[0], tr[1]); *(unsigned*)(zr + 256) = cvt_pk_bf16(ti[0], ti[1]); }
    }
}
__device__ __forceinline__ void phase_fftpre(const Args& a, LAS unsigned char* lds) {
    const int tid = threadIdx.x, lane = tid & 63, wave = tid >> 6;
    const int gw = blockIdx.x * 8 + wave, NGW = gridDim.x * 8;
    LAS float* tb = (LAS float*)(lds + XCH_OFF);
    if (tid < 32) tb[tid] = cospif((float)tid * (1.0f / 16.0f));
    __syncthreads();
    const bf16_t* Ft = (const bf16_t*)(a.ws + WS_FT); bf16_t* Z = (bf16_t*)(a.ws + WS_Z);
    constexpr float SCP = 0.022097086912079608f, SCS = 0.011048543456039806f;
    {
        float xa[8][4], xb[8][4]; const int s2 = lane * 4;
        int base, cnt, stride;
        if (gridDim.x == 256) { stride = 1024; if (blockIdx.x < 128) { base = blockIdx.x * 8 + wave; cnt = 6; } else { base = 6144 + (blockIdx.x - 128) * 8 + wave; cnt = 10; } }
        else { stride = NGW; base = gw; cnt = (16384 - gw + NGW - 1) / NGW; }
#define FP_LOAD(k, X) do { const int it_ = base + stride * (k); fftpre_load<8, 4>(Ft + (size_t)(it_ >> 9) * SEQ_P * 512, SEQ_P, it_ & 511, s2, X); } while (0)
#define FP_COMP(k, X) do { const int it_ = base + stride * (k); fftpre_compute<8, 4>(X, Z + (size_t)(it_ >> 9) * 2560 * 512, SEQ_P, it_ & 511, s2, tb, SCP); } while (0)
        if (cnt > 0) FP_LOAD(0, xa);
        for (int k = 0; k < cnt; k += 2) {
            if (k + 1 < cnt) FP_LOAD(k + 1, xb);
            FP_COMP(k, xa);
            if (k + 2 < cnt) FP_LOAD(k + 2, xa);
            if (k + 1 < cnt) FP_COMP(k + 1, xb);
        }
#undef FP_LOAD
#undef FP_COMP
    }
    for (int j = gw; j < 2048; j += NGW) { const int z = j >> 10, c = (j >> 1) & 511, s2 = (j & 1) * 128 + lane * 2;
        float xs[32][2];
        fftpre_load<32, 2>(Ft + ((size_t)TP + (size_t)z * SEQ_S) * 512, SEQ_S, c, s2, xs);
        fftpre_compute<32, 2>(xs, Z + ((size_t)32 * 2560 + (size_t)z * 8704) * 512, SEQ_S, c, s2, tb, SCS); }
}

__device__ __forceinline__ int sgu_swz(int c) { return (c ^ (c >> 4)) & 15; }
__device__ __forceinline__ void phase_sgu(const Args& a, LAS unsigned char* lds) {
    const int tid = threadIdx.x, lane = tid & 63, wave = tid >> 6, fr = lane & 15, fq = lane >> 4;
    const bf16_t* V = (const bf16_t*)(a.ws + WS_V); const bf16_t* U = (const bf16_t*)(a.ws + WS_U); bf16_t* SG = (bf16_t*)(a.ws + WS_SG); const bf16_t* WS = (const bf16_t*)(a.ws + WS_WS);
    float lg[8], lb[8];
#pragma unroll
    for (int e = 0; e < 8; ++e) { lg[e] = a.ln_g[lane * 8 + e]; lb[e] = a.ln_b[lane * 8 + e]; }
    for (int item = blockIdx.x; item < T / 128; item += gridDim.x) {
        const int t0 = item * 128;
        __syncthreads();
#pragma unroll
        for (int qb = 0; qb < 2; ++qb) {
            u32x4 raw[8]; float x[8][8], s[8], s2[8];
#pragma unroll
            for (int qq = 0; qq < 8; ++qq) raw[qq] = *(const u32x4*)(V + (size_t)(t0 + wave * 16 + qb * 8 + qq) * 512 + lane * 8);
#pragma unroll
            for (int qq = 0; qq < 8; ++qq) { const u32x4 r = raw[qq];
                x[qq][0] = bflo(r.x); x[qq][1] = bfhi(r.x); x[qq][2] = bflo(r.y); x[qq][3] = bfhi(r.y); x[qq][4] = bflo(r.z); x[qq][5] = bfhi(r.z); x[qq][6] = bflo(r.w); x[qq][7] = bfhi(r.w);
                s[qq] = ((x[qq][0] + x[qq][1]) + (x[qq][2] + x[qq][3])) + ((x[qq][4] + x[qq][5]) + (x[qq][6] + x[qq][7])); }
#pragma unroll
            for (int qq = 0; qq < 8; ++qq) s[qq] = row16_sum(s[qq]);
#pragma unroll
            for (int o = 16; o < 64; o <<= 1) {
#pragma unroll
                for (int qq = 0; qq < 8; ++qq) s[qq] += __shfl_xor(s[qq], o); }
#pragma unroll
            for (int qq = 0; qq < 8; ++qq) { const float mu = s[qq] * (1.0f / 512.0f); float t = 0.f;
#pragma unroll
                for (int e = 0; e < 8; ++e) { x[qq][e] -= mu; t += x[qq][e] * x[qq][e]; }
                s2[qq] = t; }
#pragma unroll
            for (int qq = 0; qq < 8; ++qq) s2[qq] = row16_sum(s2[qq]);
#pragma unroll
            for (int o = 16; o < 64; o <<= 1) {
#pragma unroll
                for (int qq = 0; qq < 8; ++qq) s2[qq] += __shfl_xor(s2[qq], o); }
#pragma unroll
            for (int qq = 0; qq < 8; ++qq) s2[qq] = rsqrtf(s2[qq] * (1.0f / 512.0f) + EPS);
#pragma unroll
            for (int e = 0; e < 8; ++e) { const int c = 8 * (lane & 15) + e;
                u32x4 w;
                w.x = cvt_pk_bf16(x[0][e] * s2[0] * lg[e] + lb[e], x[1][e] * s2[1] * lg[e] + lb[e]); w.y = cvt_pk_bf16(x[2][e] * s2[2] * lg[e] + lb[e], x[3][e] * s2[3] * lg[e] + lb[e]);
                w.z = cvt_pk_bf16(x[4][e] * s2[4] * lg[e] + lb[e], x[5][e] * s2[5] * lg[e] + lb[e]); w.w = cvt_pk_bf16(x[6][e] * s2[6] * lg[e] + lb[e], x[7][e] * s2[7] * lg[e] + lb[e]);
                *(LAS u32x4*)(lds + (lane >> 4) * 32768 + c * 256 + (((wave * 2 + qb) ^ sgu_swz(c)) << 4)) = w; }
        }
        __syncthreads();
        const int p = wave * 16 + fr;
#pragma unroll 1
        for (int hh = 0; hh < 4; ++hh) {
            f32x4 acc[8]; bf16x8 af[4]; u32x2 uu[8];
#pragma unroll
            for (int kk = 0; kk < 4; ++kk) af[kk] = *(const bf16x8*)(WS + (size_t)(hh * 128 + p) * 128 + kk * 32 + fq * 8);
#pragma unroll
            for (int nt = 0; nt < 8; ++nt) uu[nt] = *(const u32x2*)(U + (size_t)(t0 + p) * 512 + hh * 128 + nt * 16 + 4 * fq);
            const float bs = a.b_s[hh * 128 + p];
#pragma unroll
            for (int nt = 0; nt < 8; ++nt) acc[nt] = (f32x4){0.f, 0.f, 0.f, 0.f};
#pragma unroll
            for (int kk = 0; kk < 4; ++kk) {
#pragma unroll
                for (int nt = 0; nt < 8; ++nt) { const int c = nt * 16 + fr;
                    const bf16x8 bfm = *(const LAS bf16x8*)(lds + hh * 32768 + c * 256 + (((kk * 4 + fq) ^ sgu_swz(c)) << 4));
                    acc[nt] = __builtin_amdgcn_mfma_f32_16x16x32_bf16(bfm, af[kk], acc[nt], 0, 0, 0); }
            }
#pragma unroll
            for (int nt = 0; nt < 8; ++nt) { u32x2 o;
                o.x = cvt_pk_bf16(bflo(uu[nt].x) * (acc[nt][0] + bs), bfhi(uu[nt].x) * (acc[nt][1] + bs)); o.y = cvt_pk_bf16(bflo(uu[nt].y) * (acc[nt][2] + bs), bfhi(uu[nt].y) * (acc[nt][3] + bs));
                *(u32x2*)(SG + (size_t)(t0 + p) * 512 + hh * 128 + nt * 16 + 4 * fq) = o; }
        }
    }
}

__device__ __forceinline__ void phase_mid(const Args& a) {
    const int tid = threadIdx.x, lane = tid & 63, wave = tid >> 6;
    const int gw = blockIdx.x * 8 + wave, NGW = gridDim.x * 8;
    const bf16_t* O = (const bf16_t*)(a.ws + WS_O); const float* SS = (const float*)(a.ws + WS_SS1); bf16_t* H2 = (bf16_t*)(a.ws + WS_H2);
    f32x4 g1[4], g2[4];
#pragma unroll
    for (int j = 0; j < 4; ++j) { g1[j] = *(const f32x4*)(a.g_post_mix + 4 * lane + 256 * j); g2[j] = *(const f32x4*)(a.g_pre_ffn + 4 * lane + 256 * j); }
    for (int row0 = gw * 4; row0 < T; row0 += NGW * 4) {
        f32x4 v[4][4]; u32x2 ob[4][4]; float ss[4], s2[4];
#pragma unroll
        for (int rr = 0; rr < 4; ++rr) { const int row = row0 + rr; const float* xr = row < TP ? a.xp + (size_t)row * D : a.xs + (size_t)(row - TP) * D;
            ss[rr] = lane < 16 ? SS[(size_t)row * 16 + lane] : 0.f;
#pragma unroll
            for (int j = 0; j < 4; ++j) { v[rr][j] = *(const f32x4*)(xr + 4 * lane + 256 * j); ob[rr][j] = *(const u32x2*)(O + (size_t)row * D + 4 * lane + 256 * j); } }
#pragma unroll
        for (int rr = 0; rr < 4; ++rr) ss[rr] = row16_sum(ss[rr]);
#pragma unroll
        for (int rr = 0; rr < 4; ++rr) { const float r1 = rsqrtf(__shfl(ss[rr], 0) * (1.0f / D) + EPS); float t = 0.f;
#pragma unroll
            for (int j = 0; j < 4; ++j) { const u32x2 o = ob[rr][j];
                v[rr][j][0] += bflo(o.x) * r1 * g1[j][0]; v[rr][j][1] += bfhi(o.x) * r1 * g1[j][1]; v[rr][j][2] += bflo(o.y) * r1 * g1[j][2]; v[rr][j][3] += bfhi(o.y) * r1 * g1[j][3];
                t += (v[rr][j][0] * v[rr][j][0] + v[rr][j][1] * v[rr][j][1]) + (v[rr][j][2] * v[rr][j][2] + v[rr][j][3] * v[rr][j][3]); }
            s2[rr] = t; }
#pragma unroll
        for (int rr = 0; rr < 4; ++rr) s2[rr] = wave_sum(s2[rr]);
#pragma unroll
        for (int rr = 0; rr < 4; ++rr) { const float r2 = rsqrtf(s2[rr] * (1.0f / D) + EPS);
#pragma unroll
            for (int j = 0; j < 4; ++j) { *(f32x4*)(a.out + (size_t)(row0 + rr) * D + 4 * lane + 256 * j) = v[rr][j];
                u32x2 o; o.x = cvt_pk_bf16(v[rr][j][0] * r2 * g2[j][0], v[rr][j][1] * r2 * g2[j][1]); o.y = cvt_pk_bf16(v[rr][j][2] * r2 * g2[j][2], v[rr][j][3] * r2 * g2[j][3]);
                *(u32x2*)(H2 + (size_t)(row0 + rr) * D + 4 * lane + 256 * j) = o; } }
    }
}

__device__ __forceinline__ void fix_panel(const Args& a, int pm) {
    const float* SB = (const float*)(a.ws + WS_SB); bf16_t* ACT = (bf16_t*)(a.ws + WS_ACT);
    for (int idx = threadIdx.x; idx < 2 * 1024; idx += 512) {
        const int f = (idx & 1023) * 4, sd = idx >> 10;
        const int t = pm * 256 + (sd ? 255 : 0);
        bool edge;
        if (sd == 0) edge = t < TP ? ((t & (SEQ_P - 1)) == 0) : (((t - TP) & (SEQ_S - 1)) == 0);
        else edge = t < TP ? (((t + 1) & (SEQ_P - 1)) == 0) : (((t + 1 - TP) & (SEQ_S - 1)) == 0);
        float upv[2][4];
#pragma unroll
        for (int hh = 0; hh < 2; ++hh) { const int col = hh * 4096 + f;
            f32x4 pv = (f32x4){0.f, 0.f, 0.f, 0.f}, nv = (f32x4){0.f, 0.f, 0.f, 0.f}, cv;
            if (sd == 0) { cv = *(const f32x4*)(SB + ((size_t)pm * 4 + 0) * 8192 + col); nv = *(const f32x4*)(SB + ((size_t)pm * 4 + 1) * 8192 + col);
                if (!edge) pv = *(const f32x4*)(SB + ((size_t)(pm - 1) * 4 + 3) * 8192 + col); }
            else { cv = *(const f32x4*)(SB + ((size_t)pm * 4 + 3) * 8192 + col); pv = *(const f32x4*)(SB + ((size_t)pm * 4 + 2) * 8192 + col);
                if (!edge) nv = *(const f32x4*)(SB + ((size_t)(pm + 1) * 4 + 0) * 8192 + col); }
            const f32x4 w0 = *(const f32x4*)(a.conv_w + col), w1 = *(const f32x4*)(a.conv_w + 8192 + col), w2 = *(const f32x4*)(a.conv_w + 16384 + col), bb = *(const f32x4*)(a.conv_b + col);
#pragma unroll
            for (int j = 0; j < 4; ++j) upv[hh][j] = w0[j] * pv[j] + w1[j] * cv[j] + w2[j] * nv[j] + bb[j]; }
        u32x2 w; w.x = cvt_pk_bf16(gelu_f(upv[0][0]) * upv[1][0], gelu_f(upv[0][1]) * upv[1][1]); w.y = cvt_pk_bf16(gelu_f(upv[0][2]) * upv[1][2], gelu_f(upv[0][3]) * upv[1][3]);
        *(u32x2*)(ACT + (size_t)t * DFF + f) = w;
    }
}

__device__ __forceinline__ void phase_final(const Args& a) {
    const int tid = threadIdx.x, lane = tid & 63, wave = tid >> 6;
    const int gw = blockIdx.x * 8 + wave, NGW = gridDim.x * 8;
    const bf16_t* FF = (const bf16_t*)(a.ws + WS_FF); const float* SS = (const float*)(a.ws + WS_SS2);
    f32x4 g1[4];
#pragma unroll
    for (int j = 0; j < 4; ++j) g1[j] = *(const f32x4*)(a.g_post_ffn + 4 * lane + 256 * j);
    for (int row0 = gw * 4; row0 < T; row0 += NGW * 4) {
        f32x4 v[4][4]; u32x2 ob[4][4]; float ss[4];
#pragma unroll
        for (int rr = 0; rr < 4; ++rr) { const int row = row0 + rr;
            ss[rr] = lane < 16 ? SS[(size_t)row * 16 + lane] : 0.f;
#pragma unroll
            for (int j = 0; j < 4; ++j) { v[rr][j] = *(const f32x4*)(a.out + (size_t)row * D + 4 * lane + 256 * j); ob[rr][j] = *(const u32x2*)(FF + (size_t)row * D + 4 * lane + 256 * j); } }
#pragma unroll
        for (int rr = 0; rr < 4; ++rr) ss[rr] = row16_sum(ss[rr]);
#pragma unroll
        for (int rr = 0; rr < 4; ++rr) { const float r1 = rsqrtf(__shfl(ss[rr], 0) * (1.0f / D) + EPS);
#pragma unroll
            for (int j = 0; j < 4; ++j) { const u32x2 o = ob[rr][j]; f32x4 x = v[rr][j];
                x[0] += bflo(o.x) * r1 * g1[j][0]; x[1] += bfhi(o.x) * r1 * g1[j][1]; x[2] += bflo(o.y) * r1 * g1[j][2]; x[3] += bfhi(o.y) * r1 * g1[j][3];
                *(f32x4*)(a.out + (size_t)(row0 + rr) * D + 4 * lane + 256 * j) = x; } }
    }
}

__device__ __forceinline__ void late_transposes(const Args& a, LAS unsigned char* lds, int widx, int wcount) {
    const int lane = threadIdx.x & 63, wave = threadIdx.x >> 6;
    LAS float* scr = (LAS float*)(lds + wave * 8448);
    constexpr int I_UP = (D / 64) * (2 * DFF / 32), I_DN = (DFF / 64) * (D / 32);
    for (int it = widx; it < I_UP + I_DN; it += wcount) {
        if (it < I_UP) p0_transpose_item(a.w_up, D, 2 * DFF, (bf16_t*)(a.ws + WS_WUP), scr, it, lane);
        else p0_transpose_item(a.w_down, DFF, D, (bf16_t*)(a.ws + WS_WDN), scr, it - I_UP, lane);
    }
}

#define XB_TMO      128
#define XB_XCNT(j)  (256  + 64 * (j))
#define XB_XSUB(j)  (1280 + 64 * (j))
#define XB_XGEN(j)  (2304 + 64 * (j))
#define XB_TOP      3328
#define XB_TOPGEN   3392
#define XCD_BAR_WORDS 3456
#define XB_SPIN_CAP (1u << 18)
__device__ __forceinline__ unsigned xb_ld(unsigned* p)              { return __hip_atomic_load(p, __ATOMIC_RELAXED, __HIP_MEMORY_SCOPE_AGENT); }
__device__ __forceinline__ unsigned xb_add(unsigned* p, unsigned v) { return __hip_atomic_fetch_add(p, v, __ATOMIC_RELAXED, __HIP_MEMORY_SCOPE_AGENT); }
__device__ __forceinline__ unsigned xb_xcc_id() { return (unsigned)__builtin_amdgcn_s_getreg((3 << 11) | 20) & 0xFu; }
#define XB_SPIN(cond, bar) do { unsigned _sp = 0; while (cond) { __builtin_amdgcn_s_sleep(1); \
    if ((++_sp & 255u) == 0u) { if (xb_ld(&(bar)[XB_TMO])) break; if (_sp > XB_SPIN_CAP) { atomicAdd(&(bar)[XB_TMO], 1u); break; } } } } while (0)
struct XcdBarrier { unsigned* bar; unsigned x; volatile LAS unsigned* st; };
__device__ __forceinline__ XcdBarrier xcd_barrier_post(unsigned* bar, volatile LAS unsigned* st) {
    XcdBarrier b; b.bar = bar; b.x = xb_xcc_id(); b.st = st;
    if (threadIdx.x == 0) (void)xb_add(&bar[XB_XCNT(b.x)], 1u);
    return b;
}
__device__ __forceinline__ void xcd_barrier_complete(unsigned* bar, unsigned x, unsigned& nloc, unsigned& nx) {
    const unsigned G = gridDim.x * gridDim.y * gridDim.z;
    unsigned sum, cnt, mine, sp = 0u;
    for (;;) {
        sum = 0u; cnt = 0u; mine = 0u;
#pragma unroll
        for (unsigned j = 0; j < 16; ++j) { const unsigned c = xb_ld(&bar[XB_XCNT(j)]); sum += c; cnt += (c > 0u) ? 1u : 0u; mine = (j == x) ? c : mine; }
        if (sum == G) break;
        __builtin_amdgcn_s_sleep(1);
        if ((++sp & 255u) == 0u) { if (xb_ld(&bar[XB_TMO])) break; if (sp > XB_SPIN_CAP) { atomicAdd(&bar[XB_TMO], 1u); break; } }
    }
    nloc = mine > 0u ? mine : 1u; nx = cnt > 0u ? cnt : 1u;
}
__device__ __forceinline__ void xcd_barrier(const XcdBarrier& b) {
    asm volatile("s_waitcnt vmcnt(0)" ::: "memory");
    __syncthreads();
    if (threadIdx.x == 0) {
        unsigned* bar = b.bar;
        __builtin_amdgcn_s_waitcnt(0);
        unsigned nloc = b.st[0], nx = b.st[1];
        if (nloc == 0u) { xcd_barrier_complete(bar, b.x, nloc, nx); b.st[0] = nloc; b.st[1] = nx; }
        const unsigned old = xb_add(&bar[XB_XSUB(b.x)], 1u);
        const unsigned gen = old / nloc;
        if (old + 1u == (gen + 1u) * nloc) {
            __builtin_amdgcn_fence(__ATOMIC_RELEASE, "agent");
            asm volatile("s_waitcnt vmcnt(0)" ::: "memory");
            const unsigned og = xb_add(&bar[XB_TOP], 1u);
            const unsigned tg = og / nx;
            if (og + 1u == (tg + 1u) * nx) xb_add(&bar[XB_TOPGEN], 1u);
            else XB_SPIN(xb_ld(&bar[XB_TOPGEN]) == tg, bar);
            __builtin_amdgcn_fence(__ATOMIC_ACQUIRE, "agent");
            xb_add(&bar[XB_XGEN(b.x)], 1u);
            asm volatile("s_waitcnt vmcnt(0)" ::: "memory");
        } else {
            XB_SPIN(xb_ld(&bar[XB_XGEN(b.x)]) == gen, bar);
            __builtin_amdgcn_fence(__ATOMIC_ACQUIRE, "agent");
            asm volatile("s_waitcnt vmcnt(0)" ::: "memory");
        }
    }
    __syncthreads();
}

constexpr int NPHASE = 10;
__global__ void __launch_bounds__(512) fwd_kernel(Args a) {
    extern __shared__ __attribute__((aligned(16))) unsigned char smem[];
    LAS unsigned char* lds = (LAS unsigned char*)smem;
    unsigned char* ws = a.ws;
    const int G = gridDim.x, c = blockIdx.x;
#ifndef PH_MASK
#define PH_MASK 0x3ff
#endif
#define IN(p) (((PH_MASK >> (p)) & 1) && a.ph_lo <= (p) && (p) < a.ph_hi)
    volatile LAS unsigned* bst = (volatile LAS unsigned*)(lds + BAR_ST_OFF);
    const bool multi = (a.ph_lo == 0 && a.ph_hi == NPHASE);
    XcdBarrier xb; xb.bar = (unsigned*)(ws + WS_BAR); xb.x = 0; xb.st = bst;
    if (multi) {
        if (threadIdx.x < 2) bst[threadIdx.x] = 0u;
        if (blockIdx.x == 0) for (int i = threadIdx.x; i < XCD_BAR_WORDS; i += 512) (void)__hip_atomic_exchange((unsigned*)(ws + WS_BAR) + i, 0u, __ATOMIC_RELAXED, __HIP_MEMORY_SCOPE_AGENT);
        __syncthreads();
    }
#define SEAM(p) do { if (IN(p) && IN((p) + 1)) { if ((p) == 0 || !multi) cg::this_grid().sync(); else xcd_barrier(xb); } } while (0)
    if (IN(0)) phase_prep(a, lds);
    SEAM(0);
    if (multi) xb = xcd_barrier_post((unsigned*)(ws + WS_BAR), bst);
    if (IN(1)) {
        FlatSched S; S.nM = T / 256; S.nN = NPROJ / 256; S.nwg = S.nM * S.nN; S.G = G; S.c = c; S.A = (const char*)(ws + WS_H); S.B = (const char*)(ws + WS_WIN); S.tstepA = 256 * D * 2; S.tstepB = 256 * D * 2;
        EpiInProj E; E.Ft = (bf16_t*)(ws + WS_FT); E.wsb = ws;
        gemm_phase(lds, D, D, D, (size_t)HALF * D * 2, S, E);
        { const int rem = S.nwg % G, nshort = rem ? G - rem : G;
          if (c >= (rem ? rem : 0)) late_transposes(a, lds, (c - (rem ? rem : 0)) * 8 + (threadIdx.x >> 6), nshort * 8); }
    }
    SEAM(1);
    if (IN(2)) { if (a.p0mask & 32) phase_fftpre(a, lds); __syncthreads(); if (a.p0mask & 64) phase_sgu(a, lds); }
    SEAM(2);
    if (IN(3)) {
        FftSched S; S.c = c; S.G = G; S.A = (const char*)(ws + WS_WM); S.B = (const char*)(ws + WS_Z);
        EpiFft E; E.FM = (bf16_t*)(ws + WS_FM);
        gemm_phase(lds, 512, 512, 512, (size_t)HALF * 512 * 2, S, E);
    }
    SEAM(3);
    if (IN(4)) {
        FlatSched S; S.nM = T / 256; S.nN = 4; S.nwg = S.nM * S.nN; S.G = G; S.c = c;
        { S.A = (const char*)(ws + WS_FM); S.B = (const char*)(ws + WS_WFO); S.tstepA = 256 * 1024 * 2; S.tstepB = 256 * 1024 * 2;
          EpiMerge<0> E; E.Y = (bf16_t*)(ws + WS_MG); E.G = (const bf16_t*)(ws + WS_G);
          gemm_phase(lds, 1024, 1024, 1024, (size_t)HALF * 1024 * 2, S, E); }
        { S.A = (const char*)(ws + WS_SG); S.B = (const char*)(ws + WS_WSO); S.tstepA = 256 * 512 * 2; S.tstepB = 256 * 512 * 2;
          EpiMerge<1> E; E.Y = (bf16_t*)(ws + WS_MG); E.G = (const bf16_t*)(ws + WS_G);
          gemm_phase(lds, 512, 512, 512, (size_t)HALF * 512 * 2, S, E); }
    }
    SEAM(4);
    if (IN(5)) {
        FlatSched S; S.nM = T / 256; S.nN = 4; S.nwg = S.nM * S.nN; S.G = G; S.c = c; S.A = (const char*)(ws + WS_MG); S.B = (const char*)(ws + WS_WO); S.tstepA = 256 * 1024 * 2; S.tstepB = 256 * 1024 * 2;
        EpiRowSS E; E.O = (bf16_t*)(ws + WS_O); E.SSQ = (float*)(ws + WS_SS1);
        gemm_phase(lds, 1024, 1024, 1024, (size_t)HALF * 1024 * 2, S, E);
    }
    SEAM(5);
    if (IN(6)) phase_mid(a);
    SEAM(6);
    if (IN(7)) {
        FlatSched S; S.nM = T / 256; S.nN = 32; S.nwg = S.nM * S.nN; S.G = G; S.c = c; S.A = (const char*)(ws + WS_H2); S.B = (const char*)(ws + WS_WUP); S.tstepA = 256 * 1024 * 2; S.tstepB = 128 * 1024 * 2;
        EpiUp E; E.ACT = (bf16_t*)(ws + WS_ACT); E.SB = (float*)(ws + WS_SB); E.cw = a.conv_w; E.cb = a.conv_b; E.X = (LAS float*)(lds + XCH_OFF);
        gemm_phase(lds, 1024, 1024, 1024, (size_t)DFF * 1024 * 2, S, E);
    }
    SEAM(7);
    if (IN(8)) {
        FlatSched S; S.nM = T / 256; S.nN = 4; S.nwg = S.nM * S.nN; S.G = G; S.c = c; S.A = (const char*)(ws + WS_ACT); S.B = (const char*)(ws + WS_WDN); S.tstepA = (size_t)256 * DFF * 2; S.tstepB = (size_t)256 * DFF * 2;
        { Unit fu; for (int i = 0; S.next(i, fu); ++i) fix_panel(a, fu.pm); }
        asm volatile("s_waitcnt vmcnt(0)" ::: "memory"); __syncthreads();
        EpiRowSS E; E.O = (bf16_t*)(ws + WS_FF); E.SSQ = (float*)(ws + WS_SS2);
        gemm_phase(lds, DFF, DFF, DFF, (size_t)HALF * DFF * 2, S, E);
    }
    SEAM(8);
    if (IN(9)) phase_final(a);
#undef IN
#undef SEAM
}

extern "C" void kernel_launch(void* const* d_in, const int* in_sizes, int n_in, void* d_out, int out_size, void* d_ws, size_t ws_size, hipStream_t stream) {
    static int grid = 0;
    if (grid == 0) {
        if (n_in != 18 || in_sizes[0] != TP * D || out_size != T * D || ws_size < WS_END) { fprintf(stderr, "kernel_launch: unexpected shapes / workspace (n_in %d, ws %zu, need %zu)\n", n_in, ws_size, (size_t)WS_END); grid = -1; return; }
        int dev = 0, cus = 0, per_cu = 0;
        hipGetDevice(&dev); hipDeviceGetAttribute(&cus, hipDeviceAttributeMultiprocessorCount, dev);
        if (hipFuncSetAttribute((const void*)fwd_kernel, hipFuncAttributeMaxDynamicSharedMemorySize, LDS_BYTES) != hipSuccess) { fprintf(stderr, "kernel_launch: hipFuncSetAttribute failed\n"); grid = -1; return; }
        if (hipOccupancyMaxActiveBlocksPerMultiprocessor(&per_cu, (const void*)fwd_kernel, 512, LDS_BYTES) != hipSuccess || per_cu < 1) { fprintf(stderr, "kernel_launch: occupancy query says %d\n", per_cu); per_cu = 1; }
        (void)hipGetLastError();
        grid = cus;
    }
    if (grid < 0) return;
    Args a{};
    a.xp = (const float*)d_in[0]; a.xs = (const float*)d_in[1]; a.g_pre_mix = (const float*)d_in[2]; a.w_in = (const float*)d_in[3]; a.ln_g = (const float*)d_in[4]; a.ln_b = (const float*)d_in[5];
    a.w_s = (const float*)d_in[6]; a.b_s = (const float*)d_in[7]; a.w_fo = (const float*)d_in[8]; a.w_so = (const float*)d_in[9]; a.w_o = (const float*)d_in[10]; a.g_post_mix = (const float*)d_in[11];
    a.g_pre_ffn = (const float*)d_in[12]; a.w_up = (const float*)d_in[13]; a.conv_w = (const float*)d_in[14]; a.conv_b = (const float*)d_in[15]; a.w_down = (const float*)d_in[16]; a.g_post_ffn = (const float*)d_in[17];
    a.out = (float*)d_out; a.ws = (unsigned char*)d_ws; a.p0mask = 0x7f;
#if MK_MULTI
    for (int p = 0; p < NPHASE; ++p) { a.ph_lo = p; a.ph_hi = p + 1; hipLaunchKernelGGL(fwd_kernel, dim3(grid), dim3(512), LDS_BYTES, stream, a); }
#else
    a.ph_lo = 0; a.ph_hi = NPHASE;
    void* args[] = {&a};
    hipError_t e = hipLaunchCooperativeKernel((const void*)fwd_kernel, dim3(grid), dim3(512), args, LDS_BYTES, stream);
    if (e != hipSuccess) fprintf(stderr, "cooperative launch failed: %s (grid %d)\n", hipGetErrorString(e), grid);
#ifdef PROBE_PHASE
    a.ph_lo = PROBE_PHASE; a.ph_hi = PROBE_PHASE + 1; a.p0mask = PROBE_P0MASK; hipLaunchKernelGGL(fwd_kernel, dim3(grid), dim3(512), LDS_BYTES, stream, a);
#endif
#endif
}
```

```cpp
#include <hip/hip_runtime.h>
#include <hip/hip_cooperative_groups.h>
#include <cstdio>
#include <cstdint>
namespace cg = cooperative_groups;

#ifndef PROBE_P0MASK
#define PROBE_P0MASK 0x7f
#endif
#ifndef MK_MULTI
#define MK_MULTI 0
#endif

#define LAS __attribute__((address_space(3)))
typedef unsigned short bf16_t;
typedef short bf16x8 __attribute__((ext_vector_type(8)));
typedef float f32x4 __attribute__((ext_vector_type(4)));
typedef unsigned u32x4 __attribute__((ext_vector_type(4)));
typedef unsigned u32x2 __attribute__((ext_vector_type(2)));

constexpr int T = 81920, TP = 65536, D = 1024, NPROJ = 3584, DFF = 4096;
constexpr int SEQ_P = 2048, SEQ_S = 8192;
constexpr float EPS = 1e-6f;
constexpr size_t MiB = 1ull << 20;
constexpr size_t WS_WIN = 0, WS_WFO = 7 * MiB, WS_WSO = 9 * MiB, WS_WO = 10 * MiB, WS_WUP = 12 * MiB, WS_WDN = 28 * MiB, WS_WS = 36 * MiB;
constexpr size_t WS_WM = 40 * MiB, WS_Z = 41 * MiB;
constexpr size_t WS_H = 176 * MiB, WS_FM = 176 * MiB;
constexpr size_t WS_FT = 336 * MiB, WS_V = 416 * MiB, WS_U = 496 * MiB, WS_G = 576 * MiB;
constexpr size_t WS_MG = 336 * MiB, WS_O = 576 * MiB, WS_H2 = 40 * MiB, WS_ACT = 200 * MiB, WS_SB = 840 * MiB, WS_FF = 40 * MiB;
constexpr size_t WS_BAR = 976 * MiB;
constexpr size_t WS_SG = 896 * MiB;
constexpr size_t WS_SS1 = 880 * MiB, WS_SS2 = 885 * MiB, WS_END = 977 * MiB;

constexpr int BM = 256, BK = 64, HALF = 128, HTB = HALF * BK * 2, STAGE_BYTES = 8 * HTB, NXCD = 8, WGM = 8;
constexpr int XCH_OFF = STAGE_BYTES, XCH_BYTES = 8192, BAR_ST_OFF = STAGE_BYTES + XCH_BYTES, LDS_BYTES = STAGE_BYTES + XCH_BYTES + 16;

struct Args {
    const float *xp, *xs, *g_pre_mix, *w_in, *ln_g, *ln_b, *w_s, *b_s, *w_fo, *w_so, *w_o, *g_post_mix, *g_pre_ffn, *w_up, *conv_w, *conv_b, *w_down, *g_post_ffn;
    float* out; unsigned char* ws; int ph_lo, ph_hi, p0mask, pad_;
};

__device__ __forceinline__ unsigned cvt_pk_bf16(float lo, float hi) { unsigned r; asm volatile("v_cvt_pk_bf16_f32 %0, %1, %2" : "=v"(r) : "v"(lo), "v"(hi)); return r; }
__device__ __forceinline__ bf16_t f2bf(float x) { return (bf16_t)(cvt_pk_bf16(x, x) & 0xffffu); }
__device__ __forceinline__ float bflo(unsigned u) { return __uint_as_float(u << 16); }
__device__ __forceinline__ float bfhi(unsigned u) { return __uint_as_float(u & 0xffff0000u); }
template <int CTRL> __device__ __forceinline__ float dppx(float x) { return __builtin_bit_cast(float, __builtin_amdgcn_mov_dpp(__builtin_bit_cast(int, x), CTRL, 0xf, 0xf, true)); }
__device__ __forceinline__ float row16_sum(float v) { v += dppx<0xB1>(v); v += dppx<0x4E>(v); v += dppx<0x141>(v); v += dppx<0x128>(v); return v; }
__device__ __forceinline__ float wave_sum(float v) { v = row16_sum(v); v += __shfl_xor(v, 16); v += __shfl_xor(v, 32); return v; }
__device__ __forceinline__ float sigmoid_f(float x) { return __builtin_amdgcn_rcpf(1.0f + __builtin_amdgcn_exp2f(-1.4426950409f * x)); }
__device__ __forceinline__ float gelu_f(float x) {
    const float q = x * __builtin_fmaf(x * x, -0.10294324f, -2.3022082f);
    return x * __builtin_amdgcn_rcpf(1.0f + __builtin_amdgcn_exp2f(q));
}
#define LDS_WAIT() asm volatile("s_waitcnt lgkmcnt(0)" ::: "memory")

__device__ __forceinline__ int lds_byte(int r, int c) { const int st = (r >> 4) * 2 + (c >> 5), rr = r & 15, cc = c & 31, ob = rr * 64 + cc * 2; return st * 1024 + (ob ^ (((ob >> 9) & 1) << 5)); }
__device__ __forceinline__ void stage_rc(int b, int& R, int& C) { const int st = b / 1024, sb = b % 1024, swz = sb ^ (((sb >> 9) & 1) << 5); R = (st >> 1) * 16 + swz / 64; C = (st & 1) * 32 + (swz % 64) / 2; }
__device__ __forceinline__ int perm32(int rho) { const int n = rho >> 4, i = rho & 15; return 8 * (i >> 2) + 4 * n + (i & 3); }

struct Unit { int pm, pn, z; };

struct FlatSched {
    int nM, nN, nwg, G, c; const char *A, *B; size_t tstepA, tstepB;
    __device__ __forceinline__ bool next(int i, Unit& u) const {
        const long L = (long)i * G + c; if (L >= nwg) return false;
        int wgid = (int)L; { const int q = nwg / NXCD, r = nwg % NXCD, xcd = wgid % NXCD, off = wgid / NXCD; wgid = (xcd < r ? xcd * (q + 1) : r * (q + 1) + (xcd - r) * q) + off; }
        const int nig = WGM * nN, gid = wgid / nig, fm = gid * WGM, gsz = (nM - fm) < WGM ? (nM - fm) : WGM;
        u.pm = fm + ((wgid % nig) % gsz); u.pn = (wgid % nig) / gsz; u.z = 0; return true;
    }
    __device__ __forceinline__ const char* aptr(const Unit& u) const { return A + (size_t)u.pm * tstepA; }
    __device__ __forceinline__ const char* bptr(const Unit& u) const { return B + (size_t)u.pn * tstepB; }
};
struct FftSched {
    int c, G; const char *A, *B;
    __device__ __forceinline__ bool next(int i, Unit& u) const {
        const int L = i * G + c; if (L >= 776) return false;
        if (L < 640) { u.z = L / 20; const int r = L % 20; u.pm = r & 1; u.pn = r >> 1; }
        else { const int L2 = L - 640; u.z = 32 + L2 / 68; const int r = L2 % 68; u.pm = r & 1; u.pn = r >> 1; }
        return true;
    }
    __device__ __forceinline__ const char* aptr(const Unit& u) const { return A + (size_t)u.pm * 256 * 512 * 2; }
    __device__ __forceinline__ const char* bptr(const Unit& u) const { const size_t zrow0 = u.z < 32 ? (size_t)u.z * 2560 : (size_t)32 * 2560 + (size_t)(u.z - 32) * 8704; return B + (zrow0 + (size_t)u.pn * 256) * 512 * 2; }
};

template <class E> struct RowPerm { static constexpr bool v = false; };
struct EpiUp; template <> struct RowPerm<EpiUp> { static constexpr bool v = true; };
template <class Epi, class Sched>
__device__ __forceinline__ void gemm_phase(LAS unsigned char* lds, const int K, const int lda, const int ldb, const size_t hstepB, const Sched& S, const Epi& E) {
    const int tid = threadIdx.x, wid = __builtin_amdgcn_readfirstlane(tid >> 6), lane = tid & 63, wr = wid >> 2, wc = wid & 3, fr = lane & 15, fq = lane >> 4;
    const int nt = K / BK;
    unsigned voffA[2], voffB[2];
#pragma unroll
    for (int i = 0; i < 2; ++i) { int R, C; stage_rc(tid * 16 + i * 8192, R, C); const int Rb = (R & ~31) + perm32(R & 31);
        const int Ra = RowPerm<Epi>::v ? ((R & ~63) + 4 * (R & 15) + ((R >> 4) & 3)) : R;
        voffA[i] = (unsigned)(Ra * lda + C) * 2u; voffB[i] = (unsigned)(Rb * ldb + C) * 2u; }
    const size_t kstep = (size_t)(BK * 2);
    const size_t hstepA = (size_t)HALF * lda * 2;
    const unsigned ldsw = (unsigned)wid * 1024u;
    const int aoff = lds_byte(wr * 64 + fr, fq * 8), boff = lds_byte(wc * 32 + fr, fq * 8);
#define PG8_SA(b, h) (((b) * 2 + (h)) * HTB)
#define PG8_SB(b, h) ((4 + (b) * 2 + (h)) * HTB)
#define PG8_STAGE(bufoff, gbase, voff) do { _Pragma("unroll") for (int _i = 0; _i < 2; ++_i) \
        __builtin_amdgcn_global_load_lds((const unsigned*)((const char*)(gbase) + (voff)[_i]), (LAS unsigned*)(lds + (bufoff) + ldsw + _i * 8192), 16, 0, 0); } while (0)
#define PG8_LDA(dst, b, h) do { _Pragma("unroll") for (int m = 0; m < 4; ++m) _Pragma("unroll") for (int k = 0; k < 2; ++k) dst[m][k] = *(const LAS bf16x8*)(lds + PG8_SA(b, h) + aoff + m * 2048 + k * 1024); } while (0)
#define PG8_LDB(dst, b, h) do { _Pragma("unroll") for (int n = 0; n < 2; ++n) _Pragma("unroll") for (int k = 0; k < 2; ++k) dst[n][k] = *(const LAS bf16x8*)(lds + PG8_SB(b, h) + boff + n * 2048 + k * 1024); } while (0)
#define PG8_MMA(ai, bj, At, Bt) do { __builtin_amdgcn_s_setprio(1); _Pragma("unroll") for (int m = 0; m < 4; ++m) _Pragma("unroll") for (int n = 0; n < 2; ++n) _Pragma("unroll") for (int k = 0; k < 2; ++k) \
        acc[ai][bj][m][n] = __builtin_amdgcn_mfma_f32_16x16x32_bf16(Bt[n][k], At[m][k], acc[ai][bj][m][n], 0, 0, 0); __builtin_amdgcn_s_setprio(0); } while (0)
#define PG8_WAIT_V(n) asm volatile("s_waitcnt vmcnt(" #n ")" ::: "memory")
#define PG8_WAIT_L(n) asm volatile("s_waitcnt lgkmcnt(" #n ")" ::: "memory")
#define PG8_BAR __builtin_amdgcn_s_barrier()
#define PG8_SCHED __builtin_amdgcn_sched_barrier(0)
    Unit cur, nxt; int ui = 0;
    if (!S.next(0, cur)) return;
    f32x4 acc[2][2][4][2];
#pragma unroll
    for (int a = 0; a < 2; ++a)
#pragma unroll
        for (int b = 0; b < 2; ++b)
#pragma unroll
            for (int m = 0; m < 4; ++m)
#pragma unroll
                for (int n = 0; n < 2; ++n) acc[a][b][m][n] = (f32x4){0.f, 0.f, 0.f, 0.f};
    bf16x8 At[4][2], B0[2][2], B1[2][2];
    const char* cA = S.aptr(cur); const char* cB = S.bptr(cur);
    PG8_STAGE(PG8_SB(0, 0), cB, voffB); PG8_STAGE(PG8_SB(0, 1), cB + hstepB, voffB); PG8_STAGE(PG8_SA(0, 0), cA, voffA); PG8_STAGE(PG8_SA(0, 1), cA + hstepA, voffA);
    if (wr == 1) PG8_BAR;
    PG8_WAIT_V(2); PG8_BAR;
    PG8_STAGE(PG8_SB(1, 0), cB + kstep, voffB); PG8_STAGE(PG8_SA(1, 0), cA + kstep, voffA); PG8_STAGE(PG8_SB(1, 1), cB + hstepB + kstep, voffB);
    PG8_WAIT_V(6); PG8_BAR;
    for (;;) {
        const bool has_next = S.next(ui + 1, nxt);
        const char* nA = has_next ? S.aptr(nxt) : cA; const char* nB = has_next ? S.bptr(nxt) : cB;
        for (int t = 0; t < nt; t += 2) {
            const bool last = (t == nt - 2);
            const char* a1 = cA + (size_t)(t + 1) * kstep;
            const char* a2 = last ? nA : cA + (size_t)(t + 2) * kstep; const char* b2 = last ? nB : cB + (size_t)(t + 2) * kstep;
            const char* a3 = a2 + kstep; const char* b3 = b2 + kstep;
            PG8_LDB(B0, 0, 0); PG8_LDB(B1, 0, 1); PG8_SCHED; PG8_LDA(At, 0, 0); PG8_STAGE(PG8_SA(1, 1), a1 + hstepA, voffA);
            PG8_WAIT_V(8); PG8_WAIT_L(0); PG8_BAR; PG8_MMA(0, 0, At, B0); PG8_MMA(0, 1, At, B1); PG8_BAR; PG8_SCHED;
            PG8_LDA(At, 0, 1); PG8_STAGE(PG8_SB(0, 0), b2, voffB); PG8_STAGE(PG8_SB(0, 1), b2 + hstepB, voffB); PG8_STAGE(PG8_SA(0, 0), a2, voffA);
            PG8_WAIT_V(8); PG8_WAIT_L(0); PG8_BAR; PG8_MMA(1, 0, At, B0); PG8_MMA(1, 1, At, B1); PG8_BAR; PG8_SCHED;
            PG8_LDB(B0, 1, 0); PG8_LDB(B1, 1, 1); PG8_SCHED; PG8_LDA(At, 1, 0); PG8_STAGE(PG8_SA(0, 1), a2 + hstepA, voffA);
            PG8_WAIT_V(8); PG8_WAIT_L(0); PG8_BAR; PG8_MMA(0, 0, At, B0); PG8_MMA(0, 1, At, B1); PG8_BAR; PG8_SCHED;
            PG8_LDA(At, 1, 1); PG8_STAGE(PG8_SB(1, 0), b3, voffB); PG8_STAGE(PG8_SB(1, 1), b3 + hstepB, voffB); PG8_STAGE(PG8_SA(1, 0), a3, voffA);
            PG8_WAIT_V(8); PG8_WAIT_L(0); PG8_BAR; PG8_MMA(1, 0, At, B0); PG8_MMA(1, 1, At, B1); PG8_BAR; PG8_SCHED;
        }
        if (wr == 0) PG8_BAR;
        E(acc, cur, wr, wc, fr, fq);
        if (!has_next) break;
#pragma unroll
        for (int a = 0; a < 2; ++a)
#pragma unroll
            for (int b = 0; b < 2; ++b)
#pragma unroll
                for (int m = 0; m < 4; ++m)
#pragma unroll
                    for (int n = 0; n < 2; ++n) acc[a][b][m][n] = (f32x4){0.f, 0.f, 0.f, 0.f};
        cur = nxt; cA = nA; cB = nB; ++ui;
        if (wr == 1) PG8_BAR;
    }
    PG8_WAIT_V(0);
    PG8_BAR;
#undef PG8_SA
#undef PG8_SB
#undef PG8_STAGE
#undef PG8_LDA
#undef PG8_LDB
#undef PG8_MMA
#undef PG8_WAIT_V
#undef PG8_WAIT_L
#undef PG8_BAR
#undef PG8_SCHED
}

typedef f32x4 AccT[2][2][4][2];

struct EpiInProj {
    bf16_t* Ft; unsigned char* wsb;
    __device__ __forceinline__ void operator()(const AccT& acc, const Unit& u, int wr, int wc, int fr, int fq) const {
        const int tb = u.pm * BM;
        if (u.pn < 2) {
            int S, ts0; if (tb < TP) { S = SEQ_P; ts0 = tb & ~(SEQ_P - 1); } else { S = SEQ_S; ts0 = TP + ((tb - TP) & ~(SEQ_S - 1)); }
            bf16_t* ft = Ft + (size_t)ts0 * 512 + (tb - ts0 + wr * 64 + fr);
#pragma unroll
            for (int bj = 0; bj < 2; ++bj)
#pragma unroll
                for (int n = 0; n < 2; ++n) { const int c0 = 256 * u.pn + 128 * bj + 32 * wc + 8 * fq + 4 * n;
#pragma unroll
                    for (int j = 0; j < 4; ++j) { bf16_t* cp = ft + (size_t)(c0 + j) * S;
#pragma unroll
                        for (int ai = 0; ai < 2; ++ai)
#pragma unroll
                            for (int m = 0; m < 4; ++m) cp[ai * HALF + m * 16] = f2bf(acc[ai][bj][m][n][j]); } }
        } else {
            const bool sig = u.pn >= 6; const size_t isU = u.pn < 4 ? 1 : 0, isV = (u.pn >= 4 && u.pn < 6) ? 1 : 0;
            bf16_t* base = (bf16_t*)(wsb + WS_G + isU * (WS_U - WS_G) + isV * (WS_V - WS_G));
            const int ldc = sig ? 2048 : 512, colt = sig ? (u.pn - 6) * 256 : ((u.pn - 2) & 1) * 256;
            const int row0 = tb + wr * 64 + fr, col0 = colt + wc * 32 + 8 * fq;
#pragma unroll
            for (int ai = 0; ai < 2; ++ai)
#pragma unroll
                for (int m = 0; m < 4; ++m) { bf16_t* rowp = base + (size_t)(row0 + ai * HALF + m * 16) * ldc + col0;
#pragma unroll
                    for (int bj = 0; bj < 2; ++bj) { f32x4 v0 = acc[ai][bj][m][0], v1 = acc[ai][bj][m][1];
                        if (sig) {
#pragma unroll
                            for (int j = 0; j < 4; ++j) { v0[j] = sigmoid_f(v0[j]); v1[j] = sigmoid_f(v1[j]); }
                        } else {
#pragma unroll
                            for (int j = 0; j < 4; ++j) { v0[j] = gelu_f(v0[j]); v1[j] = gelu_f(v1[j]); }
                        }
                        u32x4 w; w.x = cvt_pk_bf16(v0[0], v0[1]); w.y = cvt_pk_bf16(v0[2], v0[3]); w.z = cvt_pk_bf16(v1[0], v1[1]); w.w = cvt_pk_bf16(v1[2], v1[3]);
                        *(u32x4*)(rowp + bj * HALF) = w; } }
        }
    }
};

struct EpiFft {
    bf16_t* FM;
    __device__ __forceinline__ void operator()(const AccT& acc, const Unit& u, int wr, int wc, int fr, int fq) const {
        int S, N1, tok0; if (u.z < 32) { S = SEQ_P; N1 = 8; tok0 = u.z * SEQ_P; } else { S = SEQ_S; N1 = 32; tok0 = TP + (u.z - 32) * SEQ_S; }
        const int k1 = u.pn >> 1, ch = u.pn & 1, part = u.pm; const bool mirror = k1 > 0 && k1 < (N1 >> 1);
        const int c0 = part * 512 + ch * 256 + 32 * wc + 8 * fq;
#pragma unroll
        for (int ai = 0; ai < 2; ++ai)
#pragma unroll
            for (int m = 0; m < 4; ++m) { const int k2 = ai * HALF + wr * 64 + m * 16 + fr, k = k1 + N1 * k2;
#pragma unroll
                for (int bj = 0; bj < 2; ++bj) { const f32x4 v0 = acc[ai][bj][m][0], v1 = acc[ai][bj][m][1];
                    u32x4 w; w.x = cvt_pk_bf16(v0[0], v0[1]); w.y = cvt_pk_bf16(v0[2], v0[3]); w.z = cvt_pk_bf16(v1[0], v1[1]); w.w = cvt_pk_bf16(v1[2], v1[3]);
                    *(u32x4*)(FM + (size_t)(tok0 + k) * 1024 + c0 + bj * HALF) = w;
                    if (mirror) { if (part) { w.x ^= 0x80008000u; w.y ^= 0x80008000u; w.z ^= 0x80008000u; w.w ^= 0x80008000u; }
                        *(u32x4*)(FM + (size_t)(tok0 + S - k) * 1024 + c0 + bj * HALF) = w; }
                } }
    }
};

template <int MODE> struct EpiMerge {
    bf16_t* Y; const bf16_t* G;
    __device__ __forceinline__ void operator()(const AccT& acc, const Unit& u, int wr, int wc, int fr, int fq) const {
        const int row0 = u.pm * BM + wr * 64 + fr, col0 = u.pn * BM + wc * 32 + 8 * fq;
#pragma unroll
        for (int ai = 0; ai < 2; ++ai)
#pragma unroll
            for (int m = 0; m < 4; ++m) { const size_t row = (size_t)(row0 + ai * HALF + m * 16);
#pragma unroll
                for (int bj = 0; bj < 2; ++bj) { const f32x4 v0 = acc[ai][bj][m][0], v1 = acc[ai][bj][m][1];
                    const u32x4 g = *(const u32x4*)(G + row * 2048 + MODE * 1024 + col0 + bj * HALF);
                    float r[8] = {bflo(g.x) * v0[0], bfhi(g.x) * v0[1], bflo(g.y) * v0[2], bfhi(g.y) * v0[3], bflo(g.z) * v1[0], bfhi(g.z) * v1[1], bflo(g.w) * v1[2], bfhi(g.w) * v1[3]};
                    bf16_t* yp = Y + row * 1024 + col0 + bj * HALF;
                    if (MODE == 1) { const u32x4 y = *(const u32x4*)yp;
                        r[0] += bflo(y.x); r[1] += bfhi(y.x); r[2] += bflo(y.y); r[3] += bfhi(y.y); r[4] += bflo(y.z); r[5] += bfhi(y.z); r[6] += bflo(y.w); r[7] += bfhi(y.w); }
                    u32x4 w; w.x = cvt_pk_bf16(r[0], r[1]); w.y = cvt_pk_bf16(r[2], r[3]); w.z = cvt_pk_bf16(r[4], r[5]); w.w = cvt_pk_bf16(r[6], r[7]);
                    *(u32x4*)yp = w; } }
    }
};

struct EpiRowSS {
    bf16_t* O; float* SSQ;
    __device__ __forceinline__ void operator()(const AccT& acc, const Unit& u, int wr, int wc, int fr, int fq) const {
        const int row0 = u.pm * BM + wr * 64 + fr, col0 = u.pn * BM + wc * 32 + 8 * fq;
#pragma unroll
        for (int ai = 0; ai < 2; ++ai)
#pragma unroll
            for (int m = 0; m < 4; ++m) { const size_t row = (size_t)(row0 + ai * HALF + m * 16); float s = 0.f;
#pragma unroll
                for (int bj = 0; bj < 2; ++bj) { const f32x4 v0 = acc[ai][bj][m][0], v1 = acc[ai][bj][m][1];
                    s += (v0[0] * v0[0] + v0[1] * v0[1]) + (v0[2] * v0[2] + v0[3] * v0[3]) + (v1[0] * v1[0] + v1[1] * v1[1]) + (v1[2] * v1[2] + v1[3] * v1[3]);
                    u32x4 w; w.x = cvt_pk_bf16(v0[0], v0[1]); w.y = cvt_pk_bf16(v0[2], v0[3]); w.z = cvt_pk_bf16(v1[0], v1[1]); w.w = cvt_pk_bf16(v1[2], v1[3]);
                    *(u32x4*)(O + row * 1024 + col0 + bj * HALF) = w; }
                s += __shfl_xor(s, 16); s += __shfl_xor(s, 32);
                if (fq == 0) SSQ[row * 16 + u.pn * 4 + wc] = s; }
    }
};

typedef _Float16 h2_t __attribute__((ext_vector_type(2)));
__device__ __forceinline__ h2_t pk_h2(float a, float b) { return __builtin_bit_cast(h2_t, __builtin_amdgcn_cvt_pkrtz(a, b)); }
template <int CTRL> __device__ __forceinline__ h2_t dpp_h2(h2_t x) { return __builtin_bit_cast(h2_t, __builtin_amdgcn_mov_dpp(__builtin_bit_cast(int, x), CTRL, 0xf, 0xf, true)); }
__device__ __forceinline__ h2_t sel_h2(bool c, h2_t a, h2_t b) { return __builtin_bit_cast(h2_t, c ? __builtin_bit_cast(int, a) : __builtin_bit_cast(int, b)); }
template <int CTRL> __device__ __forceinline__ float dpp_f(float x) { return __builtin_bit_cast(float, __builtin_amdgcn_update_dpp(0, __builtin_bit_cast(int, x), CTRL, 0xf, 0xf, false)); }
struct EpiUp {
    bf16_t* ACT; float* SB; const float *cw, *cb; LAS float* X;
    __device__ __forceinline__ void operator()(const AccT& acc, const Unit& u, int wr, int wc, int fr, int fq) const {
        const int ccb = 32 * wc + 8 * fq;
#pragma unroll
        for (int ai = 0; ai < 2; ++ai) { const int q4 = ai * 2 + wr;
#pragma unroll
            for (int bj = 0; bj < 2; ++bj)
#pragma unroll
                for (int n = 0; n < 2; ++n) {
                    if (fr == 0) *(LAS f32x4*)(X + ((q4 * 2 + 0) * 2 + bj) * 128 + ccb + 4 * n) = acc[ai][bj][0][n];
                    if (fr == 15) *(LAS f32x4*)(X + ((q4 * 2 + 1) * 2 + bj) * 128 + ccb + 4 * n) = acc[ai][bj][3][n];
                    const int scol = bj * 4096 + 128 * u.pn + ccb + 4 * n;
                    if (q4 == 0 && fr == 0) { *(f32x4*)(SB + ((size_t)u.pm * 4 + 0) * 8192 + scol) = acc[ai][bj][0][n]; *(f32x4*)(SB + ((size_t)u.pm * 4 + 1) * 8192 + scol) = acc[ai][bj][1][n]; }
                    if (q4 == 3 && fr == 15) { *(f32x4*)(SB + ((size_t)u.pm * 4 + 2) * 8192 + scol) = acc[ai][bj][2][n]; *(f32x4*)(SB + ((size_t)u.pm * 4 + 3) * 8192 + scol) = acc[ai][bj][3][n]; }
                } }
        LDS_WAIT(); __builtin_amdgcn_s_barrier(); asm volatile("" ::: "memory");
        unsigned keep[2][4][2];
#pragma unroll
        for (int n = 0; n < 2; ++n) {
            const int colg = 128 * u.pn + ccb + 4 * n;
            h2_t w0[2][2], w1[2][2], w2[2][2], bb[2][2];
#pragma unroll
            for (int bj = 0; bj < 2; ++bj) { const int col = bj * 4096 + colg;
                const f32x4 a0 = *(const f32x4*)(cw + col), a1 = *(const f32x4*)(cw + 8192 + col), a2 = *(const f32x4*)(cw + 16384 + col), ab = *(const f32x4*)(cb + col);
                w0[bj][0] = pk_h2(a0[0], a0[1]); w0[bj][1] = pk_h2(a0[2], a0[3]); w1[bj][0] = pk_h2(a1[0], a1[1]); w1[bj][1] = pk_h2(a1[2], a1[3]);
                w2[bj][0] = pk_h2(a2[0], a2[1]); w2[bj][1] = pk_h2(a2[2], a2[3]); bb[bj][0] = pk_h2(ab[0], ab[1]); bb[bj][1] = pk_h2(ab[2], ab[3]); }
            const h2_t C1 = (h2_t){(_Float16)-2.3022082f, (_Float16)-2.3022082f}, C2 = (h2_t){(_Float16)-0.10294324f, (_Float16)-0.10294324f}, ONE = (h2_t){(_Float16)1.0f, (_Float16)1.0f};
#pragma unroll
            for (int ai = 0; ai < 2; ++ai) { const int q4 = ai * 2 + wr;
                h2_t xp[2][2], xn[2][2], ch[2][4][2];
#pragma unroll
                for (int bj = 0; bj < 2; ++bj) {
                    f32x4 fp = (f32x4){0.f, 0.f, 0.f, 0.f}, fn = (f32x4){0.f, 0.f, 0.f, 0.f};
                    if (fr == 15 && q4 > 0) fp = *(const LAS f32x4*)(X + (((q4 - 1) * 2 + 1) * 2 + bj) * 128 + ccb + 4 * n);
                    if (fr == 0 && q4 < 3) fn = *(const LAS f32x4*)(X + (((q4 + 1) * 2 + 0) * 2 + bj) * 128 + ccb + 4 * n);
                    xp[bj][0] = pk_h2(fp[0], fp[1]); xp[bj][1] = pk_h2(fp[2], fp[3]); xn[bj][0] = pk_h2(fn[0], fn[1]); xn[bj][1] = pk_h2(fn[2], fn[3]);
#pragma unroll
                    for (int m = 0; m < 4; ++m) { const f32x4 v = acc[ai][bj][m][n]; ch[bj][m][0] = pk_h2(v[0], v[1]); ch[bj][m][1] = pk_h2(v[2], v[3]); }
                }
#pragma unroll
                for (int m = 0; m < 4; ++m) {
                    unsigned wq[2];
#pragma unroll
                    for (int pr = 0; pr < 2; ++pr) {
                        h2_t up[2];
#pragma unroll
                        for (int bj = 0; bj < 2; ++bj) {
                            const h2_t cur = ch[bj][m][pr];
                            h2_t pv, nv;
                            if (m == 0) pv = dpp_h2<0x121>(sel_h2(fr == 15, xp[bj][pr], ch[bj][3][pr]));
                            else pv = ch[bj][m == 0 ? 0 : m - 1][pr];
                            if (m == 3) nv = dpp_h2<0x12F>(sel_h2(fr == 0, xn[bj][pr], ch[bj][0][pr]));
                            else nv = ch[bj][m == 3 ? 3 : m + 1][pr];
                            h2_t r = __builtin_elementwise_fma(w1[bj][pr], cur, bb[bj][pr]);
                            r = __builtin_elementwise_fma(w0[bj][pr], pv, r);
                            r = __builtin_elementwise_fma(w2[bj][pr], nv, r);
                            up[bj] = r;
                        }
                        const h2_t g = up[0], q = g * __builtin_elementwise_fma(g * g, C2, C1);
                        const h2_t d = __builtin_elementwise_exp2(q) + ONE;
                        h2_t rc; rc.x = __builtin_amdgcn_rcph(d.x); rc.y = __builtin_amdgcn_rcph(d.y);
                        const h2_t o = (g * rc) * up[1];
                        wq[pr] = cvt_pk_bf16((float)o.x, (float)o.y);
                    }
                    if (n == 0) { keep[ai][m][0] = wq[0]; keep[ai][m][1] = wq[1]; }
                    else { u32x4 w; w.x = keep[ai][m][0]; w.y = keep[ai][m][1]; w.z = wq[0]; w.w = wq[1];
                        const size_t row = (size_t)(u.pm * BM + ai * HALF + wr * 64 + 4 * fr + m);
                        *(u32x4*)(ACT + row * DFF + 128 * u.pn + ccb) = w; }
                } }
        }
    }
};

__device__ __forceinline__ void p0_transpose_item(const float* W, int K, int N, bf16_t* WT, LAS float* scr, int item, int lane) {
    const int nblk = N / 32, kb = item / nblk, nb = item % nblk, k0 = 64 * kb, n0 = 32 * nb;
#pragma unroll
    for (int i = 0; i < 32; ++i) { const int kk = 2 * i + (lane >> 5); scr[kk * 33 + (lane & 31)] = W[(size_t)(k0 + kk) * N + n0 + (lane & 31)]; }
    LDS_WAIT(); asm volatile("" ::: "memory");
    const int c = lane & 7;
#pragma unroll
    for (int j = 0; j < 4; ++j) { const int n = (lane >> 3) + 8 * j; const LAS float* s = scr + (8 * c) * 33 + n;
        u32x4 o; o.x = cvt_pk_bf16(s[0 * 33], s[1 * 33]); o.y = cvt_pk_bf16(s[2 * 33], s[3 * 33]); o.z = cvt_pk_bf16(s[4 * 33], s[5 * 33]); o.w = cvt_pk_bf16(s[6 * 33], s[7 * 33]);
        *(u32x4*)(WT + (size_t)(n0 + n) * K + k0 + 8 * c) = o; }
    LDS_WAIT(); asm volatile("" ::: "memory");
}

__device__ __forceinline__ void phase_prep(const Args& a, LAS unsigned char* lds) {
    const int tid = threadIdx.x, lane = tid & 63, wave = tid >> 6, G = gridDim.x;
    const bool prepw = wave < 2;
    const int gw = blockIdx.x * 2 + wave, NGW = G * 2;
    const size_t gt = (size_t)blockIdx.x * 128 + tid, NGT = (size_t)G * 128;
    const int hw = blockIdx.x * 6 + (wave - 2), NHW = G * 6;
    unsigned char* ws = a.ws;
    LAS float* scr = (LAS float*)(lds + wave * 8448);
    LAS float* tb128 = (LAS float*)(lds + 67584);
    if (tid < 128) tb128[tid] = cospif((float)tid * (1.0f / 64.0f));
    __syncthreads();
    if (prepw && (a.p0mask & 1)) {
        constexpr int I_IN = (D / 64) * (NPROJ / 32), I_SO = (512 / 64) * (D / 32), I_O = (D / 64) * (D / 32), I_UP = (D / 64) * (2 * DFF / 32), I_DN = (DFF / 64) * (D / 32);
        constexpr int NIT = I_IN + I_SO + I_O;
        (void)I_UP; (void)I_DN;
        for (int it = gw; it < NIT; it += NGW) {
            int r = it;
            if (r < I_IN) { p0_transpose_item(a.w_in, D, NPROJ, (bf16_t*)(ws + WS_WIN), scr, r, lane); continue; } r -= I_IN;
            if (r < I_SO) { p0_transpose_item(a.w_so, 512, D, (bf16_t*)(ws + WS_WSO), scr, r, lane); continue; } r -= I_SO;
            p0_transpose_item(a.w_o, D, D, (bf16_t*)(ws + WS_WO), scr, r, lane);
        }
    }
    if (prepw && (a.p0mask & 2)) {
        bf16_t* wfo = (bf16_t*)(ws + WS_WFO);
        for (int un = blockIdx.x + G * wave; un < 512; un += G * 2) {
            const int db = un & 3, cb = (un >> 2) & 15, cs = (un >> 6) & 1, g = un >> 7, d0 = db * 256 + lane * 4, c0 = cb * 8;
            const float* wp = a.w_fo + (size_t)(g * 128) * 1024 + d0;
            f32x4 acc[8];
#pragma unroll
            for (int e = 0; e < 8; ++e) acc[e] = (f32x4){0.f, 0.f, 0.f, 0.f};
#pragma unroll 8
            for (int l = 0; l < 128; ++l) { const f32x4 w = *(const f32x4*)(wp + (size_t)l * 1024);
#pragma unroll
                for (int e = 0; e < 8; ++e) { const int ph = (l * (c0 + e)) & 127; const float cf = cs ? -tb128[(ph - 32) & 127] : tb128[ph]; acc[e] += cf * w; } }
            const float sc = 0.08838834764831845f;
#pragma unroll
            for (int j = 0; j < 4; ++j) { u32x4 o; o.x = cvt_pk_bf16(acc[0][j] * sc, acc[1][j] * sc); o.y = cvt_pk_bf16(acc[2][j] * sc, acc[3][j] * sc); o.z = cvt_pk_bf16(acc[4][j] * sc, acc[5][j] * sc); o.w = cvt_pk_bf16(acc[6][j] * sc, acc[7][j] * sc);
                *(u32x4*)(wfo + (size_t)(d0 + j) * 1024 + cs * 512 + g * 128 + c0) = o; }
        }
    }
    if (prepw && (a.p0mask & 4)) {
        bf16_t* wm = (bf16_t*)(ws + WS_WM);
        for (size_t idx = gt; idx < (size_t)512 * 512; idx += NGT) {
            const int m = (int)(idx >> 9), kk = (int)(idx & 511), mm = m & 255, s2 = kk & 255;
            const float rev = (float)((mm * s2) & 255) * (1.0f / 256.0f), cv = __builtin_amdgcn_cosf(rev), sv = __builtin_amdgcn_sinf(rev);
            const float v = (m < 256) ? (kk < 256 ? cv : sv) : (kk < 256 ? sv : -cv);
            wm[idx] = f2bf(v);
        }
    }
    if (prepw && (a.p0mask & 8)) {
        bf16_t* wsb = (bf16_t*)(ws + WS_WS);
        for (size_t idx = gt; idx < 65536; idx += NGT) wsb[idx] = f2bf(a.w_s[idx]);
    }
    if (a.p0mask & 16) {
        bf16_t* H = (bf16_t*)(ws + WS_H);
        f32x4 gv[4];
#pragma unroll
        for (int j = 0; j < 4; ++j) gv[j] = *(const f32x4*)(a.g_pre_mix + 4 * lane + 256 * j);
        constexpr int R_H = 67584;
        for (int row0 = prepw ? R_H + gw * 4 : hw * 4; row0 < (prepw ? T : R_H); row0 += (prepw ? NGW : NHW) * 4) {
            f32x4 v[4][4]; float s[4];
#pragma unroll
            for (int rr = 0; rr < 4; ++rr) { const int row = row0 + rr; const float* xr = row < TP ? a.xp + (size_t)row * D : a.xs + (size_t)(row - TP) * D;
#pragma unroll
                for (int j = 0; j < 4; ++j) v[rr][j] = *(const f32x4*)(xr + 4 * lane + 256 * j); }
#pragma unroll
            for (int rr = 0; rr < 4; ++rr) { float t = 0.f;
#pragma unroll
                for (int j = 0; j < 4; ++j) t += (v[rr][j][0] * v[rr][j][0] + v[rr][j][1] * v[rr][j][1]) + (v[rr][j][2] * v[rr][j][2] + v[rr][j][3] * v[rr][j][3]);
                s[rr] = t; }
#pragma unroll
            for (int rr = 0; rr < 4; ++rr) s[rr] = wave_sum(s[rr]);
#pragma unroll
            for (int rr = 0; rr < 4; ++rr) { const float r = rsqrtf(s[rr] * (1.0f / D) + EPS);
#pragma unroll
                for (int j = 0; j < 4; ++j) { u32x2 o; o.x = cvt_pk_bf16(v[rr][j][0] * r * gv[j][0], v[rr][j][1] * r * gv[j][1]); o.y = cvt_pk_bf16(v[rr][j][2] * r * gv[j][2], v[rr][j][3] * r * gv[j][3]);
                    *(u32x2*)(H + (size_t)(row0 + rr) * D + 4 * lane + 256 * j) = o; } }
        }
    }
}

template <int N1, int VPL> __device__ __forceinline__ void fftpre_load(const bf16_t* ft, int S, int c, int s2, float (&x)[N1][VPL]) {
#pragma unroll
    for (int s1 = 0; s1 < N1; ++s1) {
        const bf16_t* p = ft + (size_t)c * S + 256 * s1 + s2;
        if (VPL == 4) { const u32x2 r = *(const u32x2*)p; x[s1][0] = bflo(r.x); x[s1][1] = bfhi(r.x); x[s1][2 % VPL] = bflo(r.y); x[s1][3 % VPL] = bfhi(r.y); }
        else { const unsigned r = *(const unsigned*)p; x[s1][0] = bflo(r); x[s1][1] = bfhi(r); }
    }
}
template <int N1, int VPL> __device__ __forceinline__ void fftpre_compute(const float (&x)[N1][VPL], bf16_t* zb, int S, int c, int s2, const LAS float* tb, float scale) {
#pragma unroll 1
    for (int k1 = 0; k1 <= N1 / 2; ++k1) {
        float yr[VPL], yi[VPL];
#pragma unroll
        for (int v = 0; v < VPL; ++v) { yr[v] = 0.f; yi[v] = 0.f; }
#pragma unroll
        for (int s1 = 0; s1 < N1; ++s1) { const int id = ((k1 * s1) & (N1 - 1)) * (32 / N1); const float cr = tb[id], sr = tb[(id - 8) & 31];
#pragma unroll
            for (int v = 0; v < VPL; ++v) { yr[v] += x[s1][v] * cr; yi[v] -= x[s1][v] * sr; } }
        float tr[VPL], ti[VPL];
#pragma unroll
        for (int v = 0; v < VPL; ++v) { const float rev = (float)(k1 * (s2 + v)) / (float)S, wr = __builtin_amdgcn_cosf(rev), wi = -__builtin_amdgcn_sinf(rev);
            tr[v] = (yr[v] * wr - yi[v] * wi) * scale; ti[v] = (yr[v] * wi + yi[v] * wr) * scale; }
        bf16_t* zr = zb + ((size_t)k1 * 512 + c) * 512 + s2;
        if (VPL == 4) { u32x2 o; o.x = cvt_pk_bf16(tr[0], tr[1]); o.y = cvt_pk_bf16(tr[2 % VPL], tr[3 % VPL]); *(u32x2*)zr = o; o.x = cvt_pk_bf16(ti[0], ti[1]); o.y = cvt_pk_bf16(ti[2 % VPL], ti[3 % VPL]); *(u32x2*)(zr + 256) = o; }
        else { *(unsigned*)zr = cvt_pk_bf16(tr[0], tr[1]); *(unsigned*)(zr + 256) = cvt_pk_bf16(ti[0], ti[1]); }
    }
}
__device__ __forceinline__ void phase_fftpre(const Args& a, LAS unsigned char* lds) {
    const int tid = threadIdx.x, lane = tid & 63, wave = tid >> 6;
    const int gw = blockIdx.x * 8 + wave, NGW = gridDim.x * 8;
    LAS float* tb = (LAS float*)(lds + XCH_OFF);
    if (tid < 32) tb[tid] = cospif((float)tid * (1.0f / 16.0f));
    __syncthreads();
    const bf16_t* Ft = (const bf16_t*)(a.ws + WS_FT); bf16_t* Z = (bf16_t*)(a.ws + WS_Z);
    constexpr float SCP = 0.022097086912079608f, SCS = 0.011048543456039806f;
    {
        float xa[8][4], xb[8][4]; const int s2 = lane * 4;
        int base, cnt, stride;
        if (gridDim.x == 256) { stride = 1024; if (blockIdx.x < 128) { base = blockIdx.x * 8 + wave; cnt = 6; } else { base = 6144 + (blockIdx.x - 128) * 8 + wave; cnt = 10; } }
        else { stride = NGW; base = gw; cnt = (16384 - gw + NGW - 1) / NGW; }
#define FP_LOAD(k, X) do { const int it_ = base + stride * (k); fftpre_load<8, 4>(Ft + (size_t)(it_ >> 9) * SEQ_P * 512, SEQ_P, it_ & 511, s2, X); } while (0)
#define FP_COMP(k, X) do { const int it_ = base + stride * (k); fftpre_compute<8, 4>(X, Z + (size_t)(it_ >> 9) * 2560 * 512, SEQ_P, it_ & 511, s2, tb, SCP); } while (0)
        if (cnt > 0) FP_LOAD(0, xa);
        for (int k = 0; k < cnt; k += 2) {
            if (k + 1 < cnt) FP_LOAD(k + 1, xb);
            FP_COMP(k, xa);
            if (k + 2 < cnt) FP_LOAD(k + 2, xa);
            if (k + 1 < cnt) FP_COMP(k + 1, xb);
        }
#undef FP_LOAD
#undef FP_COMP
    }
    for (int j = gw; j < 2048; j += NGW) { const int z = j >> 10, c = (j >> 1) & 511, s2 = (j & 1) * 128 + lane * 2;
        float xs[32][2];
        fftpre_load<32, 2>(Ft + ((size_t)TP + (size_t)z * SEQ_S) * 512, SEQ_S, c, s2, xs);
        fftpre_compute<32, 2>(xs, Z + ((size_t)32 * 2560 + (size_t)z * 8704) * 512, SEQ_S, c, s2, tb, SCS); }
}

__device__ __forceinline__ int sgu_swz(int c) { return (c ^ (c >> 4)) & 15; }
__device__ __forceinline__ void phase_sgu(const Args& a, LAS unsigned char* lds) {
    const int tid = threadIdx.x, lane = tid & 63, wave = tid >> 6, fr = lane & 15, fq = lane >> 4;
    const bf16_t* V = (const bf16_t*)(a.ws + WS_V); const bf16_t* U = (const bf16_t*)(a.ws + WS_U); bf16_t* SG = (bf16_t*)(a.ws + WS_SG); const bf16_t* WS = (const bf16_t*)(a.ws + WS_WS);
    float lg[8], lb[8];
#pragma unroll
    for (int e = 0; e < 8; ++e) { lg[e] = a.ln_g[lane * 8 + e]; lb[e] = a.ln_b[lane * 8 + e]; }
    for (int item = blockIdx.x; item < T / 128; item += gridDim.x) {
        const int t0 = item * 128;
        __syncthreads();
#pragma unroll
        for (int qb = 0; qb < 2; ++qb) {
            u32x4 raw[8]; float x[8][8], s[8], s2[8];
#pragma unroll
            for (int qq = 0; qq < 8; ++qq) raw[qq] = *(const u32x4*)(V + (size_t)(t0 + wave * 16 + qb * 8 + qq) * 512 + lane * 8);
#pragma unroll
            for (int qq = 0; qq < 8; ++qq) { const u32x4 r = raw[qq];
                x[qq][0] = bflo(r.x); x[qq][1] = bfhi(r.x); x[qq][2] = bflo(r.y); x[qq][3] = bfhi(r.y); x[qq][4] = bflo(r.z); x[qq][5] = bfhi(r.z); x[qq][6] = bflo(r.w); x[qq][7] = bfhi(r.w);
                s[qq] = ((x[qq][0] + x[qq][1]) + (x[qq][2] + x[qq][3])) + ((x[qq][4] + x[qq][5]) + (x[qq][6] + x[qq][7])); }
#pragma unroll
            for (int qq = 0; qq < 8; ++qq) s[qq] = row16_sum(s[qq]);
#pragma unroll
            for (int o = 16; o < 64; o <<= 1) {
#pragma unroll
                for (int qq = 0; qq < 8; ++qq) s[qq] += __shfl_xor(s[qq], o); }
#pragma unroll
            for (int qq = 0; qq < 8; ++qq) { const float mu = s[qq] * (1.0f / 512.0f); float t = 0.f;
#pragma unroll
                for (int e = 0; e < 8; ++e) { x[qq][e] -= mu; t += x[qq][e] * x[qq][e]; }
                s2[qq] = t; }
#pragma unroll
            for (int qq = 0; qq < 8; ++qq) s2[qq] = row16_sum(s2[qq]);
#pragma unroll
            for (int o = 16; o < 64; o <<= 1) {
#pragma unroll
                for (int qq = 0; qq < 8; ++qq) s2[qq] += __shfl_xor(s2[qq], o); }
#pragma unroll
            for (int qq = 0; qq < 8; ++qq) s2[qq] = rsqrtf(s2[qq] * (1.0f / 512.0f) + EPS);
#pragma unroll
            for (int e = 0; e < 8; ++e) { const int c = 8 * (lane & 15) + e;
                u32x4 w;
                w.x = cvt_pk_bf16(x[0][e] * s2[0] * lg[e] + lb[e], x[1][e] * s2[1] * lg[e] + lb[e]); w.y = cvt_pk_bf16(x[2][e] * s2[2] * lg[e] + lb[e], x[3][e] * s2[3] * lg[e] + lb[e]);
                w.z = cvt_pk_bf16(x[4][e] * s2[4] * lg[e] + lb[e], x[5][e] * s2[5] * lg[e] + lb[e]); w.w = cvt_pk_bf16(x[6][e] * s2[6] * lg[e] + lb[e], x[7][e] * s2[7] * lg[e] + lb[e]);
                *(LAS u32x4*)(lds + (lane >> 4) * 32768 + c * 256 + (((wave * 2 + qb) ^ sgu_swz(c)) << 4)) = w; }
        }
        __syncthreads();
        const int p = wave * 16 + fr;
#pragma unroll 1
        for (int hh = 0; hh < 4; ++hh) {
            f32x4 acc[8]; bf16x8 af[4]; u32x2 uu[8];
#pragma unroll
            for (int kk = 0; kk < 4; ++kk) af[kk] = *(const bf16x8*)(WS + (size_t)(hh * 128 + p) * 128 + kk * 32 + fq * 8);
#pragma unroll
            for (int nt = 0; nt < 8; ++nt) uu[nt] = *(const u32x2*)(U + (size_t)(t0 + p) * 512 + hh * 128 + nt * 16 + 4 * fq);
            const float bs = a.b_s[hh * 128 + p];
#pragma unroll
            for (int nt = 0; nt < 8; ++nt) acc[nt] = (f32x4){0.f, 0.f, 0.f, 0.f};
#pragma unroll
            for (int kk = 0; kk < 4; ++kk) {
#pragma unroll
                for (int nt = 0; nt < 8; ++nt) { const int c = nt * 16 + fr;
                    const bf16x8 bfm = *(const LAS bf16x8*)(lds + hh * 32768 + c * 256 + (((kk * 4 + fq) ^ sgu_swz(c)) << 4));
                    acc[nt] = __builtin_amdgcn_mfma_f32_16x16x32_bf16(bfm, af[kk], acc[nt], 0, 0, 0); }
            }
#pragma unroll
            for (int nt = 0; nt < 8; ++nt) { u32x2 o;
                o.x = cvt_pk_bf16(bflo(uu[nt].x) * (acc[nt][0] + bs), bfhi(uu[nt].x) * (acc[nt][1] + bs)); o.y = cvt_pk_bf16(bflo(uu[nt].y) * (acc[nt][2] + bs), bfhi(uu[nt].y) * (acc[nt][3] + bs));
                *(u32x2*)(SG + (size_t)(t0 + p) * 512 + hh * 128 + nt * 16 + 4 * fq) = o; }
        }
    }
}

__device__ __forceinline__ void phase_mid(const Args& a) {
    const int tid = threadIdx.x, lane = tid & 63, wave = tid >> 6;
    const int gw = blockIdx.x * 8 + wave, NGW = gridDim.x * 8;
    const bf16_t* O = (const bf16_t*)(a.ws + WS_O); const float* SS = (const float*)(a.ws + WS_SS1); bf16_t* H2 = (bf16_t*)(a.ws + WS_H2);
    f32x4 g1[4], g2[4];
#pragma unroll
    for (int j = 0; j < 4; ++j) { g1[j] = *(const f32x4*)(a.g_post_mix + 4 * lane + 256 * j); g2[j] = *(const f32x4*)(a.g_pre_ffn + 4 * lane + 256 * j); }
    for (int row0 = gw * 4; row0 < T; row0 += NGW * 4) {
        f32x4 v[4][4]; u32x2 ob[4][4]; float ss[4], s2[4];
#pragma unroll
        for (int rr = 0; rr < 4; ++rr) { const int row = row0 + rr; const float* xr = row < TP ? a.xp + (size_t)row * D : a.xs + (size_t)(row - TP) * D;
            ss[rr] = lane < 16 ? SS[(size_t)row * 16 + lane] : 0.f;
#pragma unroll
            for (int j = 0; j < 4; ++j) { v[rr][j] = *(const f32x4*)(xr + 4 * lane + 256 * j); ob[rr][j] = *(const u32x2*)(O + (size_t)row * D + 4 * lane + 256 * j); } }
#pragma unroll
        for (int rr = 0; rr < 4; ++rr) ss[rr] = row16_sum(ss[rr]);
#pragma unroll
        for (int rr = 0; rr < 4; ++rr) { const float r1 = rsqrtf(__shfl(ss[rr], 0) * (1.0f / D) + EPS); float t = 0.f;
#pragma unroll
            for (int j = 0; j < 4; ++j) { const u32x2 o = ob[rr][j];
                v[rr][j][0] += bflo(o.x) * r1 * g1[j][0]; v[rr][j][1] += bfhi(o.x) * r1 * g1[j][1]; v[rr][j][2] += bflo(o.y) * r1 * g1[j][2]; v[rr][j][3] += bfhi(o.y) * r1 * g1[j][3];
                t += (v[rr][j][0] * v[rr][j][0] + v[rr][j][1] * v[rr][j][1]) + (v[rr][j][2] * v[rr][j][2] + v[rr][j][3] * v[rr][j][3]); }
            s2[rr] = t; }
#pragma unroll
        for (int rr = 0; rr < 4; ++rr) s2[rr] = wave_sum(s2[rr]);
#pragma unroll
        for (int rr = 0; rr < 4; ++rr) { const float r2 = rsqrtf(s2[rr] * (1.0f / D) + EPS);
#pragma unroll
            for (int j = 0; j < 4; ++j) { *(f32x4*)(a.out + (size_t)(row0 + rr) * D + 4 * lane + 256 * j) = v[rr][j];
                u32x2 o; o.x = cvt_pk_bf16(v[rr][j][0] * r2 * g2[j][0], v[rr][j][1] * r2 * g2[j][1]); o.y = cvt_pk_bf16(v[rr][j][2] * r2 * g2[j][2], v[rr][j][3] * r2 * g2[j][3]);
                *(u32x2*)(H2 + (size_t)(row0 + rr) * D + 4 * lane + 256 * j) = o; } }
    }
}

__device__ __forceinline__ void fix_panel(const Args& a, int pm) {
    const float* SB = (const float*)(a.ws + WS_SB); bf16_t* ACT = (bf16_t*)(a.ws + WS_ACT);
    for (int idx = threadIdx.x; idx < 2 * 1024; idx += 512) {
        const int f = (idx & 1023) * 4, sd = idx >> 10;
        const int t = pm * 256 + (sd ? 255 : 0);
        bool edge;
        if (sd == 0) edge = t < TP ? ((t & (SEQ_P - 1)) == 0) : (((t - TP) & (SEQ_S - 1)) == 0);
        else edge = t < TP ? (((t + 1) & (SEQ_P - 1)) == 0) : (((t + 1 - TP) & (SEQ_S - 1)) == 0);
        float upv[2][4];
#pragma unroll
        for (int hh = 0; hh < 2; ++hh) { const int col = hh * 4096 + f;
            f32x4 pv = (f32x4){0.f, 0.f, 0.f, 0.f}, nv = (f32x4){0.f, 0.f, 0.f, 0.f}, cv;
            if (sd == 0) { cv = *(const f32x4*)(SB + ((size_t)pm * 4 + 0) * 8192 + col); nv = *(const f32x4*)(SB + ((size_t)pm * 4 + 1) * 8192 + col);
                if (!edge) pv = *(const f32x4*)(SB + ((size_t)(pm - 1) * 4 + 3) * 8192 + col); }
            else { cv = *(const f32x4*)(SB + ((size_t)pm * 4 + 3) * 8192 + col); pv = *(const f32x4*)(SB + ((size_t)pm * 4 + 2) * 8192 + col);
                if (!edge) nv = *(const f32x4*)(SB + ((size_t)(pm + 1) * 4 + 0) * 8192 + col); }
            const f32x4 w0 = *(const f32x4*)(a.conv_w + col), w1 = *(const f32x4*)(a.conv_w + 8192 + col), w2 = *(const f32x4*)(a.conv_w + 16384 + col), bb = *(const f32x4*)(a.conv_b + col);
#pragma unroll
            for (int j = 0; j < 4; ++j) upv[hh][j] = w0[j] * pv[j] + w1[j] * cv[j] + w2[j] * nv[j] + bb[j]; }
        u32x2 w; w.x = cvt_pk_bf16(gelu_f(upv[0][0]) * upv[1][0], gelu_f(upv[0][1]) * upv[1][1]); w.y = cvt_pk_bf16(gelu_f(upv[0][2]) * upv[1][2], gelu_f(upv[0][3]) * upv[1][3]);
        *(u32x2*)(ACT + (size_t)t * DFF + f) = w;
    }
}

__device__ __forceinline__ void phase_final(const Args& a) {
    const int tid = threadIdx.x, lane = tid & 63, wave = tid >> 6;
    const int gw = blockIdx.x * 8 + wave, NGW = gridDim.x * 8;
    const bf16_t* FF = (const bf16_t*)(a.ws + WS_FF); const float* SS = (const float*)(a.ws + WS_SS2);
    f32x4 g1[4];
#pragma unroll
    for (int j = 0; j < 4; ++j) g1[j] = *(const f32x4*)(a.g_post_ffn + 4 * lane + 256 * j);
    for (int row0 = gw * 4; row0 < T; row0 += NGW * 4) {
        f32x4 v[4][4]; u32x2 ob[4][4]; float ss[4];
#pragma unroll
        for (int rr = 0; rr < 4; ++rr) { const int row = row0 + rr;
            ss[rr] = lane < 16 ? SS[(size_t)row * 16 + lane] : 0.f;
#pragma unroll
            for (int j = 0; j < 4; ++j) { v[rr][j] = *(const f32x4*)(a.out + (size_t)row * D + 4 * lane + 256 * j); ob[rr][j] = *(const u32x2*)(FF + (size_t)row * D + 4 * lane + 256 * j); } }
#pragma unroll
        for (int rr = 0; rr < 4; ++rr) ss[rr] = row16_sum(ss[rr]);
#pragma unroll
        for (int rr = 0; rr < 4; ++rr) { const float r1 = rsqrtf(__shfl(ss[rr], 0) * (1.0f / D) + EPS);
#pragma unroll
            for (int j = 0; j < 4; ++j) { const u32x2 o = ob[rr][j]; f32x4 x = v[rr][j];
                x[0] += bflo(o.x) * r1 * g1[j][0]; x[1] += bfhi(o.x) * r1 * g1[j][1]; x[2] += bflo(o.y) * r1 * g1[j][2]; x[3] += bfhi(o.y) * r1 * g1[j][3];
                *(f32x4*)(a.out + (size_t)(row0 + rr) * D + 4 * lane + 256 * j) = x; } }
    }
}

__device__ __forceinline__ void late_transposes(const Args& a, LAS unsigned char* lds, int widx, int wcount) {
    const int lane = threadIdx.x & 63, wave = threadIdx.x >> 6;
    LAS float* scr = (LAS float*)(lds + wave * 8448);
    constexpr int I_UP = (D / 64) * (2 * DFF / 32), I_DN = (DFF / 64) * (D / 32);
    for (int it = widx; it < I_UP + I_DN; it += wcount) {
        if (it < I_UP) p0_transpose_item(a.w_up, D, 2 * DFF, (bf16_t*)(a.ws + WS_WUP), scr, it, lane);
        else p0_transpose_item(a.w_down, DFF, D, (bf16_t*)(a.ws + WS_WDN), scr, it - I_UP, lane);
    }
}

#define XB_TMO      128
#define XB_XCNT(j)  (256  + 64 * (j))
#define XB_XSUB(j)  (1280 + 64 * (j))
#define XB_XGEN(j)  (2304 + 64 * (j))
#define XB_TOP      3328
#define XB_TOPGEN   3392
#define XCD_BAR_WORDS 3456
#define XB_SPIN_CAP (1u << 18)
__device__ __forceinline__ unsigned xb_ld(unsigned* p)              { return __hip_atomic_load(p, __ATOMIC_RELAXED, __HIP_MEMORY_SCOPE_AGENT); }
__device__ __forceinline__ unsigned xb_add(unsigned* p, unsigned v) { return __hip_atomic_fetch_add(p, v, __ATOMIC_RELAXED, __HIP_MEMORY_SCOPE_AGENT); }
__device__ __forceinline__ unsigned xb_xcc_id() { return (unsigned)__builtin_amdgcn_s_getreg((3 << 11) | 20) & 0xFu; }
#define XB_SPIN(cond, bar) do { unsigned _sp = 0; while (cond) { __builtin_amdgcn_s_sleep(1); \
    if ((++_sp & 255u) == 0u) { if (xb_ld(&(bar)[XB_TMO])) break; if (_sp > XB_SPIN_CAP) { atomicAdd(&(bar)[XB_TMO], 1u); break; } } } } while (0)
struct XcdBarrier { unsigned* bar; unsigned x; volatile LAS unsigned* st; };
__device__ __forceinline__ XcdBarrier xcd_barrier_post(unsigned* bar, volatile LAS unsigned* st) {
    XcdBarrier b; b.bar = bar; b.x = xb_xcc_id(); b.st = st;
    if (threadIdx.x == 0) (void)xb_add(&bar[XB_XCNT(b.x)], 1u);
    return b;
}
__device__ __forceinline__ void xcd_barrier_complete(unsigned* bar, unsigned x, unsigned& nloc, unsigned& nx) {
    const unsigned G = gridDim.x * gridDim.y * gridDim.z;
    unsigned sum, cnt, mine, sp = 0u;
    for (;;) {
        sum = 0u; cnt = 0u; mine = 0u;
#pragma unroll
        for (unsigned j = 0; j < 16; ++j) { const unsigned c = xb_ld(&bar[XB_XCNT(j)]); sum += c; cnt += (c > 0u) ? 1u : 0u; mine = (j == x) ? c : mine; }
        if (sum == G) break;
        __builtin_amdgcn_s_sleep(1);
        if ((++sp & 255u) == 0u) { if (xb_ld(&bar[XB_TMO])) break; if (sp > XB_SPIN_CAP) { atomicAdd(&bar[XB_TMO], 1u); break; } }
    }
    nloc = mine > 0u ? mine : 1u; nx = cnt > 0u ? cnt : 1u;
}
__device__ __forceinline__ void xcd_barrier(const XcdBarrier& b) {
    asm volatile("s_waitcnt vmcnt(0)" ::: "memory");
    __syncthreads();
    if (threadIdx.x == 0) {
        unsigned* bar = b.bar;
        __builtin_amdgcn_s_waitcnt(0);
        unsigned nloc = b.st[0], nx = b.st[1];
        if (nloc == 0u) { xcd_barrier_complete(bar, b.x, nloc, nx); b.st[0] = nloc; b.st[1] = nx; }
        const unsigned old = xb_add(&bar[XB_XSUB(b.x)], 1u);
        const unsigned gen = old / nloc;
        if (old + 1u == (gen + 1u) * nloc) {
            __builtin_amdgcn_fence(__ATOMIC_RELEASE, "agent");
            asm volatile("s_waitcnt vmcnt(0)" ::: "memory");
            const unsigned og = xb_add(&bar[XB_TOP], 1u);
            const unsigned tg = og / nx;
            if (og + 1u == (tg + 1u) * nx) xb_add(&bar[XB_TOPGEN], 1u);
            else XB_SPIN(xb_ld(&bar[XB_TOPGEN]) == tg, bar);
            __builtin_amdgcn_fence(__ATOMIC_ACQUIRE, "agent");
            xb_add(&bar[XB_XGEN(b.x)], 1u);
            asm volatile("s_waitcnt vmcnt(0)" ::: "memory");
        } else {
            XB_SPIN(xb_ld(&bar[XB_XGEN(b.x)]) == gen, bar);
            __builtin_amdgcn_fence(__ATOMIC_ACQUIRE, "agent");
            asm volatile("s_waitcnt vmcnt(0)" ::: "memory");
        }
    }
    __syncthreads();
}

constexpr int NPHASE = 10;
__global__ void __launch_bounds__(512) fwd_kernel(Args a) {
    extern __shared__ __attribute__((aligned(16))) unsigned char smem[];
    LAS unsigned char* lds = (LAS unsigned char*)smem;
    unsigned char* ws = a.ws;
    const int G = gridDim.x, c = blockIdx.x;
#ifndef PH_MASK
#define PH_MASK 0x3ff
#endif
#define IN(p) (((PH_MASK >> (p)) & 1) && a.ph_lo <= (p) && (p) < a.ph_hi)
    volatile LAS unsigned* bst = (volatile LAS unsigned*)(lds + BAR_ST_OFF);
    const bool multi = (a.ph_lo == 0 && a.ph_hi == NPHASE);
    XcdBarrier xb; xb.bar = (unsigned*)(ws + WS_BAR); xb.x = 0; xb.st = bst;
    if (multi) {
        if (threadIdx.x < 2) bst[threadIdx.x] = 0u;
        if (blockIdx.x == 0) for (int i = threadIdx.x; i < XCD_BAR_WORDS; i += 512) (void)__hip_atomic_exchange((unsigned*)(ws + WS_BAR) + i, 0u, __ATOMIC_RELAXED, __HIP_MEMORY_SCOPE_AGENT);
        __syncthreads();
    }
#define SEAM(p) do { if (IN(p) && IN((p) + 1)) { if ((p) == 0 || !multi) cg::this_grid().sync(); else xcd_barrier(xb); } } while (0)
    if (IN(0)) phase_prep(a, lds);
    SEAM(0);
    if (multi) xb = xcd_barrier_post((unsigned*)(ws + WS_BAR), bst);
    if (IN(1)) {
        FlatSched S; S.nM = T / 256; S.nN = NPROJ / 256; S.nwg = S.nM * S.nN; S.G = G; S.c = c; S.A = (const char*)(ws + WS_H); S.B = (const char*)(ws + WS_WIN); S.tstepA = 256 * D * 2; S.tstepB = 256 * D * 2;
        EpiInProj E; E.Ft = (bf16_t*)(ws + WS_FT); E.wsb = ws;
        gemm_phase(lds, D, D, D, (size_t)HALF * D * 2, S, E);
        { const int rem = S.nwg % G, nshort = rem ? G - rem : G;
          if (c >= (rem ? rem : 0)) late_transposes(a, lds, (c - (rem ? rem : 0)) * 8 + (threadIdx.x >> 6), nshort * 8); }
    }
    SEAM(1);
    if (IN(2)) { if (a.p0mask & 32) phase_fftpre(a, lds); __syncthreads(); if (a.p0mask & 64) phase_sgu(a, lds); }
    SEAM(2);
    if (IN(3)) {
        FftSched S; S.c = c; S.G = G; S.A = (const char*)(ws + WS_WM); S.B = (const char*)(ws + WS_Z);
        EpiFft E; E.FM = (bf16_t*)(ws + WS_FM);
        gemm_phase(lds, 512, 512, 512, (size_t)HALF * 512 * 2, S, E);
    }
    SEAM(3);
    if (IN(4)) {
        FlatSched S; S.nM = T / 256; S.nN = 4; S.nwg = S.nM * S.nN; S.G = G; S.c = c;
        { S.A = (const char*)(ws + WS_FM); S.B = (const char*)(ws + WS_WFO); S.tstepA = 256 * 1024 * 2; S.tstepB = 256 * 1024 * 2;
          EpiMerge<0> E; E.Y = (bf16_t*)(ws + WS_MG); E.G = (const bf16_t*)(ws + WS_G);
          gemm_phase(lds, 1024, 1024, 1024, (size_t)HALF * 1024 * 2, S, E); }
        { S.A = (const char*)(ws + WS_SG); S.B = (const char*)(ws + WS_WSO); S.tstepA = 256 * 512 * 2; S.tstepB = 256 * 512 * 2;
          EpiMerge<1> E; E.Y = (bf16_t*)(ws + WS_MG); E.G = (const bf16_t*)(ws + WS_G);
          gemm_phase(lds, 512, 512, 512, (size_t)HALF * 512 * 2, S, E); }
    }
    SEAM(4);
    if (IN(5)) {
        FlatSched S; S.nM = T / 256; S.nN = 4; S.nwg = S.nM * S.nN; S.G = G; S.c = c; S.A = (const char*)(ws + WS_MG); S.B = (const char*)(ws + WS_WO); S.tstepA = 256 * 1024 * 2; S.tstepB = 256 * 1024 * 2;
        EpiRowSS E; E.O = (bf16_t*)(ws + WS_O); E.SSQ = (float*)(ws + WS_SS1);
        gemm_phase(lds, 1024, 1024, 1024, (size_t)HALF * 1024 * 2, S, E);
    }
    SEAM(5);
    if (IN(6)) phase_mid(a);
    SEAM(6);
    if (IN(7)) {
        FlatSched S; S.nM = T / 256; S.nN = 32; S.nwg = S.nM * S.nN; S.G = G; S.c = c; S.A = (const char*)(ws + WS_H2); S.B = (const char*)(ws + WS_WUP); S.tstepA = 256 * 1024 * 2; S.tstepB = 128 * 1024 * 2;
        EpiUp E; E.ACT = (bf16_t*)(ws + WS_ACT); E.SB = (float*)(ws + WS_SB); E.cw = a.conv_w; E.cb = a.conv_b; E.X = (LAS float*)(lds + XCH_OFF);
        gemm_phase(lds, 1024, 1024, 1024, (size_t)DFF * 1024 * 2, S, E);
    }
    SEAM(7);
    if (IN(8)) {
        FlatSched S; S.nM = T / 256; S.nN = 4; S.nwg = S.nM * S.nN; S.G = G; S.c = c; S.A = (const char*)(ws + WS_ACT); S.B = (const char*)(ws + WS_WDN); S.tstepA = (size_t)256 * DFF * 2; S.tstepB = (size_t)256 * DFF * 2;
        { Unit fu; for (int i = 0; S.next(i, fu); ++i) fix_panel(a, fu.pm); }
        asm volatile("s_waitcnt vmcnt(0)" ::: "memory"); __syncthreads();
        EpiRowSS E; E.O = (bf16_t*)(ws + WS_FF); E.SSQ = (float*)(ws + WS_SS2);
        gemm_phase(lds, DFF, DFF, DFF, (size_t)HALF * DFF * 2, S, E);
    }
    SEAM(8);
    if (IN(9)) phase_final(a);
#undef IN
#undef SEAM
}

extern "C" void kernel_launch(void* const* d_in, const int* in_sizes, int n_in, void* d_out, int out_size, void* d_ws, size_t ws_size, hipStream_t stream) {
    static int grid = 0;
    if (grid == 0) {
        if (n_in != 18 || in_sizes[0] != TP * D || out_size != T * D || ws_size < WS_END) { fprintf(stderr, "kernel_launch: unexpected shapes / workspace (n_in %d, ws %zu, need %zu)\n", n_in, ws_size, (size_t)WS_END); grid = -1; return; }
        int dev = 0, cus = 0, per_cu = 0;
        hipGetDevice(&dev); hipDeviceGetAttribute(&cus, hipDeviceAttributeMultiprocessorCount, dev);
        if (hipFuncSetAttribute((const void*)fwd_kernel, hipFuncAttributeMaxDynamicSharedMemorySize, LDS_BYTES) != hipSuccess) { fprintf(stderr, "kernel_launch: hipFuncSetAttribute failed\n"); grid = -1; return; }
        if (hipOccupancyMaxActiveBlocksPerMultiprocessor(&per_cu, (const void*)fwd_kernel, 512, LDS_BYTES) != hipSuccess || per_cu < 1) { fprintf(stderr, "kernel_launch: occupancy query says %d\n", per_cu); per_cu = 1; }
        (void)hipGetLastError();
        grid = cus;
    }
    if (grid < 0) return;
    Args a{};
    a.xp = (const float*)d_in[0]; a.xs = (const float*)d_in[1]; a.g_pre_mix = (const float*)d_in[2]; a.w_in = (const float*)d_in[3]; a.ln_g = (const float*)d_in[4]; a.ln_b = (const float*)d_in[5];
    a.w_s = (const float*)d_in[6]; a.b_s = (const float*)d_in[7]; a.w_fo = (const float*)d_in[8]; a.w_so = (const float*)d_in[9]; a.w_o = (const float*)d_in[10]; a.g_post_mix = (const float*)d_in[11];
    a.g_pre_ffn = (const float*)d_in[12]; a.w_up = (const float*)d_in[13]; a.conv_w = (const float*)d_in[14]; a.conv_b = (const float*)d_in[15]; a.w_down = (const float*)d_in[16]; a.g_post_ffn = (const float*)d_in[17];
    a.out = (float*)d_out; a.ws = (unsigned char*)d_ws; a.p0mask = 0x7f;
#if MK_MULTI
    for (int p = 0; p < NPHASE; ++p) { a.ph_lo = p; a.ph_hi = p + 1; hipLaunchKernelGGL(fwd_kernel, dim3(grid), dim3(512), LDS_BYTES, stream, a); }
#else
    a.ph_lo = 0; a.ph_hi = NPHASE;
    void* args[] = {&a};
    hipError_t e = hipLaunchCooperativeKernel((const void*)fwd_kernel, dim3(grid), dim3(512), args, LDS_BYTES, stream);
    if (e != hipSuccess) fprintf(stderr, "cooperative launch failed: %s (grid %d)\n", hipGetErrorString(e), grid);
#ifdef PROBE_PHASE
    a.ph_lo = PROBE_PHASE; a.ph_hi = PROBE_PHASE + 1; a.p0mask = PROBE_P0MASK; hipLaunchKernelGGL(fwd_kernel, dim3(grid), dim3(512), LDS_BYTES, stream, a);
#endif
#endif
}
```
